# Optimizing an MI355X kernel written in HIP

```python
import math
import jax, jax.numpy as jnp
from jax import lax
import numpy as np

D_MODEL = 1024
BATCH = 8
SEQ = 2048
DEPTH = 1
DEC_BATCH = 128
DEC_SEQ = 4
PAST_LEN = 2048
PAGE_SIZE = 128

W_RET = D_MODEL // 2
DK_RET = 128
DV_RET = DK_RET
H_RET = W_RET // DK_RET
W_SB = D_MODEL - W_RET
D_SB = 64
H_SB = W_SB // D_SB
MIX_WIDTH = W_RET + W_SB
IN_COLS = 4 * W_RET + 3 * W_SB
N_MEM = 256
H_X = 4
D_X = D_MODEL // H_X
D_FF = int(math.ceil(8 * D_MODEL / 3 / 128)) * 128
CHUNK = 128
Q_BLOCK = 128
ROPE_BASE = 10000.0
SB_BIAS_NEAR = 3.0
SB_BIAS_FAR = 8.0
EPS = 1e-6
F32 = jnp.float32

kernel_name = 'hymba_retention_stickbreak_macaron_step'


def rmsnorm(x, g):
    xf = x.astype(F32)
    y = xf * lax.rsqrt(jnp.mean(xf * xf, axis=-1, keepdims=True) + EPS) * g.astype(F32)
    return y.astype(x.dtype)


def swiglu(x, w_gate, w_up, w_down):
    return (jax.nn.silu(x @ w_gate) * (x @ w_up)) @ w_down


def macaron_ffn(x, g_pre, w_gate, w_up, w_down, g_post):
    return 0.5 * rmsnorm(swiglu(rmsnorm(x, g_pre), w_gate, w_up, w_down), g_post)


def rope(x, pos):
    d = x.shape[-1]
    inv = ROPE_BASE ** (-jnp.arange(0, d, 2, dtype=F32) / d)
    ang = pos.astype(F32)[:, None] * inv[None, :]
    cos = jnp.cos(ang)[None, :, None, :]
    sin = jnp.sin(ang)[None, :, None, :]
    x1, x2 = x[..., : d // 2], x[..., d // 2:]
    return jnp.concatenate([x1 * cos - x2 * sin, x1 * sin + x2 * cos], axis=-1)


def ret_log_decay():
    return jnp.log1p(-jnp.exp2(-5.0 - jnp.arange(H_RET, dtype=F32)))


def in_proj(xn, w_in, pos):
    b, l, _ = xn.shape
    p = (xn @ w_in).astype(F32)
    cuts = [W_RET, 2 * W_RET, 3 * W_RET, 4 * W_RET, 4 * W_RET + W_SB, 4 * W_RET + 2 * W_SB]
    q_r, k_r, v_r, g_r, q_s, k_s, v_s = jnp.split(p, cuts, axis=-1)
    q_r = rope(q_r.reshape(b, l, H_RET, DK_RET), pos)
    k_r = rope(k_r.reshape(b, l, H_RET, DK_RET), pos) * (DK_RET ** -0.5)
    v_r = v_r.reshape(b, l, H_RET, DV_RET)
    q_s = q_s.reshape(b, l, H_SB, D_SB)
    k_s = k_s.reshape(b, l, H_SB, D_SB)
    v_s = v_s.reshape(b, l, H_SB, D_SB)
    return q_r, k_r, v_r, g_r, q_s, k_s, v_s


def retention_chunk(q, k, v, s0):
    L = q.shape[1]
    lg = ret_log_decay()
    i = jnp.arange(L, dtype=F32)
    diff = i[:, None] - i[None, :]
    causal = diff >= 0
    dmat = jnp.where(causal[None], jnp.exp(jnp.where(causal, diff, 0.0)[None] * lg[:, None, None]), 0.0)
    scores = jnp.einsum('bihd,bjhd->bhij', q, k) * dmat[None]
    inner = jnp.einsum('bhij,bjhe->bihe', scores, v)
    cross = jnp.einsum('bihd,bhde->bihe', q, s0) * jnp.exp((i + 1.0)[:, None] * lg[None, :])[None, :, :, None]
    kd = k * jnp.exp((L - 1.0 - i)[:, None] * lg[None, :])[None, :, :, None]
    s_new = jnp.exp(L * lg)[None, :, None, None] * s0 + jnp.einsum('bjhd,bjhe->bhde', kd, v)
    return inner + cross, s_new


def retention_prompt(q, k, v):
    b, l = q.shape[0], q.shape[1]
    nc = l // CHUNK
    def to_chunks(t):
        return jnp.moveaxis(t.reshape(b, nc, CHUNK, t.shape[2], t.shape[3]), 1, 0)
    def step(s, c):
        o, s2 = retention_chunk(c[0], c[1], c[2], s)
        return s2, o
    s_init = jnp.zeros((b, H_RET, DK_RET, DV_RET), F32)
    s_fin, o = lax.scan(step, s_init, (to_chunks(q), to_chunks(k), to_chunks(v)))
    return jnp.moveaxis(o, 0, 1).reshape(b, l, H_RET, DV_RET), s_fin


def stick_breaking(q, k, v, bias):
    lq, lk = q.shape[1], k.shape[1]
    z = jnp.einsum('bqhd,bkhd->bhqk', q, k) * (D_SB ** -0.5) + bias.astype(F32)[None, :, None, None]
    t = (lk - lq) + jnp.arange(lq)
    s = jnp.arange(lk)
    mask = s[None, :] < t[:, None]
    log_1mb = jnp.where(mask, jax.nn.log_sigmoid(-z), 0.0)
    later = lax.cumsum(log_1mb, axis=3, reverse=True) - log_1mb
    a = jnp.where(mask, jnp.exp(jax.nn.log_sigmoid(z) + later), 0.0)
    return jnp.einsum('bhqk,bkhd->bqhd', a, v)


def stick_breaking_prompt(q, k, v, bias):
    l = q.shape[1]
    outs = [stick_breaking(q[:, i * Q_BLOCK:(i + 1) * Q_BLOCK], k[:, :(i + 1) * Q_BLOCK],
                           v[:, :(i + 1) * Q_BLOCK], bias)
            for i in range(l // Q_BLOCK)]
    return jnp.concatenate(outs, axis=1)


def mix_out(o_r, g_r, o_s, g_gn, w_out, dtype):
    b, l = o_r.shape[0], o_r.shape[1]
    mu = jnp.mean(o_r, axis=-1, keepdims=True)
    var = jnp.mean(jnp.square(o_r - mu), axis=-1, keepdims=True)
    o_r = (o_r - mu) * lax.rsqrt(var + EPS) * g_gn.astype(F32).reshape(H_RET, DV_RET)
    o_r = jax.nn.silu(g_r) * o_r.reshape(b, l, W_RET)
    cat = jnp.concatenate([o_r, o_s.reshape(b, l, W_SB)], axis=-1).astype(dtype)
    return cat @ w_out


def mem_kv(mem, g_mem, w_mk, w_mv):
    b, m, _ = mem.shape
    mn = rmsnorm(mem, g_mem)
    return (mn @ w_mk).reshape(b, m, H_X, D_X), (mn @ w_mv).reshape(b, m, H_X, D_X)


def cross_attn(xn, mk, mv, w_xq, w_xo):
    b, l, _ = xn.shape
    q = (xn @ w_xq).reshape(b, l, H_X, D_X).astype(F32)
    s = jnp.einsum('blhd,bmhd->bhlm', q, mk.astype(F32)) * (D_X ** -0.5)
    p = jax.nn.softmax(s, axis=-1)
    o = jnp.einsum('bhlm,bmhd->blhd', p, mv.astype(F32))
    return o.reshape(b, l, H_X * D_X).astype(xn.dtype) @ w_xo


def hybrid_layer(h, pos, mix_core, mk, mv, lw):
    (g_ffn1_pre, w_ffn1_gate, w_ffn1_up, w_ffn1_down, g_ffn1_post, g_mix_pre, w_in, g_ret_gn, w_out,
     g_mix_post, g_x_pre, w_xq, w_xo, g_x_post, g_ffn2_pre, w_ffn2_gate, w_ffn2_up, w_ffn2_down, g_ffn2_post) = lw
    h = h + macaron_ffn(h, g_ffn1_pre, w_ffn1_gate, w_ffn1_up, w_ffn1_down, g_ffn1_post)
    xn = rmsnorm(h, g_mix_pre)
    q_r, k_r, v_r, g_r, q_s, k_s, v_s = in_proj(xn, w_in, pos)
    o_r, o_s, s_new = mix_core(q_r, k_r, v_r, q_s, k_s, v_s)
    h = h + rmsnorm(mix_out(o_r, g_r, o_s, g_ret_gn, w_out, h.dtype), g_mix_post)
    h = h + rmsnorm(cross_attn(rmsnorm(h, g_x_pre), mk, mv, w_xq, w_xo), g_x_post)
    h = h + macaron_ffn(h, g_ffn2_pre, w_ffn2_gate, w_ffn2_up, w_ffn2_down, g_ffn2_post)
    return h, s_new, k_s, v_s


def setup_inputs(seed: int = 0) -> dict:
    key = jax.random.key(seed)
    ks = jax.random.split(key, 40)
    n_pages = PAST_LEN // PAGE_SIZE
    n_pool = (DEC_BATCH * n_pages * 5 + 3) // 4
    def nrm(k, shape, scale):
        return jax.random.normal(k, shape, F32) * scale
    def gain(k, n):
        return 1.0 + 0.05 * jax.random.normal(k, (DEPTH, n), F32)
    page_table = jax.random.permutation(ks[9], n_pool)[: DEC_BATCH * n_pages].reshape(DEC_BATCH, n_pages).astype(jnp.int32)
    dm = D_MODEL ** -0.5
    sb_bias = (-jnp.linspace(SB_BIAS_NEAR, SB_BIAS_FAR, H_SB, dtype=F32)[None, :]
               + 0.1 * jax.random.normal(ks[32], (DEPTH, H_SB), F32))
    return {
        'x_prompt': nrm(ks[0], (BATCH, SEQ, D_MODEL), 1.0),
        'x_sample': nrm(ks[1], (DEC_BATCH, DEC_SEQ, D_MODEL), 1.0),
        'mem_prompt': nrm(ks[2], (BATCH, N_MEM, D_MODEL), 1.0),
        'cache_ret_state': nrm(ks[3], (DEPTH, DEC_BATCH, H_RET, DK_RET, DV_RET), 0.5),
        'cache_sb_k': nrm(ks[4], (DEPTH, n_pool, PAGE_SIZE, H_SB, D_SB), 1.0),
        'cache_sb_v': nrm(ks[5], (DEPTH, n_pool, PAGE_SIZE, H_SB, D_SB), 1.0),
        'cache_mem_k': nrm(ks[6], (DEPTH, DEC_BATCH, N_MEM, H_X, D_X), 1.0),
        'cache_mem_v': nrm(ks[7], (DEPTH, DEC_BATCH, N_MEM, H_X, D_X), 1.0),
        'page_table': page_table,
        'g_ffn1_pre': gain(ks[10], D_MODEL),
        'w_ffn1_gate': nrm(ks[11], (DEPTH, D_MODEL, D_FF), dm),
        'w_ffn1_up': nrm(ks[12], (DEPTH, D_MODEL, D_FF), dm),
        'w_ffn1_down': nrm(ks[13], (DEPTH, D_FF, D_MODEL), D_FF ** -0.5),
        'g_ffn1_post': gain(ks[14], D_MODEL),
        'g_mix_pre': gain(ks[15], D_MODEL),
        'w_in': nrm(ks[16], (DEPTH, D_MODEL, IN_COLS), dm),
        'b_sb': sb_bias,
        'g_ret_gn': gain(ks[17], W_RET),
        'w_out': nrm(ks[18], (DEPTH, MIX_WIDTH, D_MODEL), MIX_WIDTH ** -0.5),
        'g_mix_post': gain(ks[19], D_MODEL),
        'g_mem': gain(ks[20], D_MODEL),
        'w_mk': nrm(ks[21], (DEPTH, D_MODEL, H_X * D_X), dm),
        'w_mv': nrm(ks[22], (DEPTH, D_MODEL, H_X * D_X), dm),
        'g_x_pre': gain(ks[23], D_MODEL),
        'w_xq': nrm(ks[24], (DEPTH, D_MODEL, H_X * D_X), dm),
        'w_xo': nrm(ks[25], (DEPTH, H_X * D_X, D_MODEL), (H_X * D_X) ** -0.5),
        'g_x_post': gain(ks[26], D_MODEL),
        'g_ffn2_pre': gain(ks[27], D_MODEL),
        'w_ffn2_gate': nrm(ks[28], (DEPTH, D_MODEL, D_FF), dm),
        'w_ffn2_up': nrm(ks[29], (DEPTH, D_MODEL, D_FF), dm),
        'w_ffn2_down': nrm(ks[30], (DEPTH, D_FF, D_MODEL), D_FF ** -0.5),
        'g_ffn2_post': gain(ks[31], D_MODEL),
    }


def reference(x_prompt, x_sample, mem_prompt, cache_ret_state, cache_sb_k, cache_sb_v, cache_mem_k, cache_mem_v,
              page_table, g_ffn1_pre, w_ffn1_gate, w_ffn1_up, w_ffn1_down, g_ffn1_post, g_mix_pre, w_in, b_sb,
              g_ret_gn, w_out, g_mix_post, g_mem, w_mk, w_mv, g_x_pre, w_xq, w_xo, g_x_post, g_ffn2_pre,
              w_ffn2_gate, w_ffn2_up, w_ffn2_down, g_ffn2_post):
    pos_p = jnp.arange(SEQ)
    pos_s = PAST_LEN + jnp.arange(x_sample.shape[1])
    hp, hs = x_prompt, x_sample
    rs_p, kp_l, vp_l, mk_l, mv_l, rs_s, ks_l, vs_l = [], [], [], [], [], [], [], []
    for l in range(DEPTH):
        lw = (g_ffn1_pre[l], w_ffn1_gate[l], w_ffn1_up[l], w_ffn1_down[l], g_ffn1_post[l], g_mix_pre[l], w_in[l],
              g_ret_gn[l], w_out[l], g_mix_post[l], g_x_pre[l], w_xq[l], w_xo[l], g_x_post[l], g_ffn2_pre[l],
              w_ffn2_gate[l], w_ffn2_up[l], w_ffn2_down[l], g_ffn2_post[l])
        bias_l = b_sb[l]

        def prompt_core(q_r, k_r, v_r, q_s, k_s, v_s):
            o_r, s_fin = retention_prompt(q_r, k_r, v_r)
            return o_r, stick_breaking_prompt(q_s, k_s, v_s, bias_l), s_fin
        mk_p, mv_p = mem_kv(mem_prompt, g_mem[l], w_mk[l], w_mv[l])
        hp, s_p, k_p, v_p = hybrid_layer(hp, pos_p, prompt_core, mk_p, mv_p, lw)

        s0 = cache_ret_state[l].astype(F32)
        kc, vc = cache_sb_k[l], cache_sb_v[l]
        def sample_core(q_r, k_r, v_r, q_s, k_s, v_s):
            o_r, s_new = retention_chunk(q_r, k_r, v_r, s0)
            b = q_s.shape[0]
            k_past = kc[page_table].reshape(b, -1, H_SB, D_SB).astype(F32)
            v_past = vc[page_table].reshape(b, -1, H_SB, D_SB).astype(F32)
            o_s = stick_breaking(q_s, jnp.concatenate([k_past, k_s], axis=1),
                                 jnp.concatenate([v_past, v_s], axis=1), bias_l)
            return o_r, o_s, s_new
        hs, s_s, k_n, v_n = hybrid_layer(hs, pos_s, sample_core, cache_mem_k[l], cache_mem_v[l], lw)

        dt = x_prompt.dtype
        rs_p.append(s_p.astype(dt)); kp_l.append(k_p.astype(dt)); vp_l.append(v_p.astype(dt))
        mk_l.append(mk_p.astype(dt)); mv_l.append(mv_p.astype(dt))
        rs_s.append(s_s.astype(dt)); ks_l.append(k_n.astype(dt)); vs_l.append(v_n.astype(dt))
    return (hp, hs, jnp.stack(rs_p), jnp.stack(kp_l), jnp.stack(vp_l), jnp.stack(mk_l), jnp.stack(mv_l),
            jnp.stack(rs_s), jnp.stack(ks_l), jnp.stack(vs_l))
```

```cpp
#include <hip/hip_runtime.h>
#include <cstdio>
#include <cstdint>
namespace pg8 {
#define PG8_LAS __attribute__((address_space(3)))
typedef unsigned short bf16_t;
typedef short bf16x8 __attribute__((ext_vector_type(8)));
typedef float f32x4 __attribute__((ext_vector_type(4)));
typedef unsigned u32x4 __attribute__((ext_vector_type(4)));
constexpr int BM = 256, BK = 64, HALF = 128, HTB = HALF * BK * 2  , STAGE_BYTES = 8 * HTB, NXCD = 8, WGM = 8;

__host__ __device__ __forceinline__ int lds_byte(int r, int c) { const int st = (r >> 4) * 2 + (c >> 5), rr = r & 15, cc = c & 31, ob = rr * 64 + cc * 2; return st * 1024 + (ob ^ (((ob >> 9) & 1) << 5)); }
__host__ __device__ __forceinline__ void stage_rc(int b, int& R, int& C) { const int st = b / 1024, sb = b % 1024, swz = sb ^ (((sb >> 9) & 1) << 5); R = (st >> 1) * 16 + swz / 64; C = (st & 1) * 32 + (swz % 64) / 2; }
__host__ __device__ __forceinline__ int perm32(int rho) { const int n = rho >> 4, i = rho & 15; return 8 * (i >> 2) + 4 * n + (i & 3); }

struct Unit { int pm, pn; };
struct Gemm { const bf16_t* A; const bf16_t* Bt; int M, N, K; };

struct StaticOrder {
    int nM, nN, nwg, G, c;
    __host__ __device__ void init(int M, int N, int G_, int c_) { nM = M / BM; nN = N / BM; nwg = nM * nN; G = G_; c = c_; }
    __host__ __device__ bool next(int i, Unit& u) const {
        const long L = (long)i * G + c; if (L >= nwg) return false;
        int wgid = (int)L; { const int q = nwg / NXCD, r = nwg % NXCD, xcd = wgid % NXCD, off = wgid / NXCD; wgid = (xcd < r ? xcd * (q + 1) : r * (q + 1) + (xcd - r) * q) + off; }
        const int nig = WGM * nN, gid = wgid / nig, fm = gid * WGM, gsz = (nM - fm) < WGM ? (nM - fm) : WGM;
        u.pm = fm + ((wgid % nig) % gsz); u.pn = (wgid % nig) / gsz; return true;
    }
    __device__ __forceinline__ void a_ready(const Unit&) const {}
    __device__ __forceinline__ void done(const Unit&) const {}
};

__device__ __forceinline__ unsigned cvt_pk_bf16(float lo, float hi) { unsigned r; asm volatile("v_cvt_pk_bf16_f32 %0, %1, %2" : "=v"(r) : "v"(lo), "v"(hi)); return r; }
typedef float f32x2 __attribute__((ext_vector_type(2)));
__device__ __forceinline__ f32x2 gelu_pk(f32x2 v) {
    const f32x2 av = __builtin_elementwise_abs(v), d = av * 0.2316418882f + 1.0f;
    f32x2 t; t.x = __builtin_amdgcn_rcpf(d.x); t.y = __builtin_amdgcn_rcpf(d.y);
    f32x2 q = t * 0.5307027145f + (-0.7265760135f); q = q * t + 0.7107068705f; q = q * t + (-0.142248368f); q = q * t + 0.127414796f; q = q * t;
    const f32x2 s = (v * v) * (-0.72134752044f);
    f32x2 e; e.x = __builtin_amdgcn_exp2f(s.x); e.y = __builtin_amdgcn_exp2f(s.y);
    const f32x2 m = v * (q * e), r = v - m;
    f32x2 o; o.x = v.x < 0.f ? m.x : r.x; o.y = v.y < 0.f ? m.y : r.y; return o;
}

template <int ACT  > struct EpiBf16 {
    static constexpr bool PERM = true, AFTER_DRAIN = false; static_assert(ACT == 0 || ACT == 1, "EpiBf16: ACT is 0 (none) or 1 (gelu_pk)");
    bf16_t* O; int ldc; const float* bias; int split_cols; size_t split_stride; float scale0;
    __device__ __forceinline__ void operator()(const f32x4 (&acc)[2][2][4][2], const Unit& u, int wr, int wc, int fr, int fq) const {
        const int row0 = u.pm * BM + wr * 64 + fr; int colt = u.pn * BM; bf16_t* base = O;
        float sc = 1.f; if (split_cols) { const int t = colt / split_cols; base += (size_t)t * split_stride; colt -= t * split_cols; if (t == 0) sc = scale0; }
        const int col0 = colt + wc * 32 + 8 * fq, bcol0 = u.pn * BM + wc * 32 + 8 * fq;
        f32x4 bv[2][2];
#pragma unroll
        for (int bj = 0; bj < 2; ++bj)
#pragma unroll
            for (int n = 0; n < 2; ++n) bv[bj][n] = bias ? *(const f32x4*)(bias + bcol0 + bj * HALF + 4 * n) : (f32x4){0.f, 0.f, 0.f, 0.f};
#pragma unroll
        for (int ai = 0; ai < 2; ++ai)
#pragma unroll
            for (int m = 0; m < 4; ++m) { bf16_t* rowp = base + (size_t)(row0 + ai * HALF + m * 16) * ldc + col0;
#pragma unroll
                for (int bj = 0; bj < 2; ++bj) { f32x4 v0 = acc[ai][bj][m][0] + bv[bj][0], v1 = acc[ai][bj][m][1] + bv[bj][1];
                    if (ACT == 1) { f32x2 a = gelu_pk((f32x2){v0[0], v0[1]}), b = gelu_pk((f32x2){v0[2], v0[3]}), c = gelu_pk((f32x2){v1[0], v1[1]}), d = gelu_pk((f32x2){v1[2], v1[3]});
                        v0 = (f32x4){a.x, a.y, b.x, b.y}; v1 = (f32x4){c.x, c.y, d.x, d.y}; }
                    v0 = v0 * sc; v1 = v1 * sc; u32x4 w; w.x = cvt_pk_bf16(v0[0], v0[1]); w.y = cvt_pk_bf16(v0[2], v0[3]); w.z = cvt_pk_bf16(v1[0], v1[1]); w.w = cvt_pk_bf16(v1[2], v1[3]);
                    *(u32x4*)(rowp + bj * HALF) = w; } }
    }
};
struct EpiF32 {
    static constexpr bool PERM = false, AFTER_DRAIN = false;
    float* C; int ldc; int split_cols; size_t split_stride;
    __device__ __forceinline__ void operator()(const f32x4 (&acc)[2][2][4][2], const Unit& u, int wr, int wc, int fr, int fq) const {
        int colt = u.pn * BM; float* base = C;
        if (split_cols) { const int t = colt / split_cols; base += (size_t)t * split_stride; colt -= t * split_cols; }
        const int row0 = u.pm * BM + wr * 64 + fr, col0 = colt + wc * 32 + 4 * fq;
#pragma unroll
        for (int ai = 0; ai < 2; ++ai)
#pragma unroll
            for (int m = 0; m < 4; ++m) { float* rowp = base + (size_t)(row0 + ai * HALF + m * 16) * ldc + col0;
#pragma unroll
                for (int bj = 0; bj < 2; ++bj)
#pragma unroll
                    for (int n = 0; n < 2; ++n) *(f32x4*)(rowp + bj * HALF + n * 16) = acc[ai][bj][m][n]; }
    }
};
template <class Epi, class Sched, bool ALIGN_EPI = false, bool SP2 = false>
__device__ __forceinline__ void gemm_phase(PG8_LAS unsigned char* lds, const Gemm g, const Sched& S, const Epi& E) {
    const int tid = threadIdx.x, wid = __builtin_amdgcn_readfirstlane(tid >> 6), lane = tid & 63, wr = wid >> 2, wc = wid & 3, fr = lane & 15, fq = lane >> 4;
    const int K = g.K, nt = K / BK;
    unsigned voffA[2], voffB[2];
#pragma unroll
    for (int i = 0; i < 2; ++i) { int R, C; stage_rc(tid * 16 + i * 8192, R, C); const int Rb = Epi::PERM ? ((R & ~31) + perm32(R & 31)) : R;
        voffA[i] = (unsigned)(R * K + C) * 2u; voffB[i] = (unsigned)(Rb * K + C) * 2u; }
    const size_t kstep = (size_t)(BK * 2);
    const size_t hstep = (size_t)HALF * K * 2;
    const size_t tstep = 2 * hstep;
    const unsigned ldsw = (unsigned)wid * 1024u;
    const int aoff = lds_byte(wr * 64 + fr, fq * 8), boff = lds_byte(wc * 32 + fr, fq * 8);
#define PG8_SA(b, h) (((b) * 2 + (h)) * HTB)
#define PG8_SB(b, h) ((4 + (b) * 2 + (h)) * HTB)
#define PG8_STAGE(bufoff, gbase, voff) do { _Pragma("unroll") for (int _i = 0; _i < 2; ++_i) \
        __builtin_amdgcn_global_load_lds((const unsigned*)((const char*)(gbase) + (voff)[_i]), (PG8_LAS unsigned*)(lds + (bufoff) + ldsw + _i * 8192), 16, 0, 0); } while (0)
#define PG8_LDA(dst, b, h) do { _Pragma("unroll") for (int m = 0; m < 4; ++m) _Pragma("unroll") for (int k = 0; k < 2; ++k) dst[m][k] = *(const PG8_LAS bf16x8*)(lds + PG8_SA(b, h) + aoff + m * 2048 + k * 1024); } while (0)
#define PG8_LDB(dst, b, h) do { _Pragma("unroll") for (int n = 0; n < 2; ++n) _Pragma("unroll") for (int k = 0; k < 2; ++k) dst[n][k] = *(const PG8_LAS bf16x8*)(lds + PG8_SB(b, h) + boff + n * 2048 + k * 1024); } while (0)
#define PG8_MMA(ai, bj, At, Bt) do { __builtin_amdgcn_s_setprio(1); _Pragma("unroll") for (int m = 0; m < 4; ++m) _Pragma("unroll") for (int n = 0; n < 2; ++n) _Pragma("unroll") for (int k = 0; k < 2; ++k) \
        acc[ai][bj][m][n] = __builtin_amdgcn_mfma_f32_16x16x32_bf16(Bt[n][k], At[m][k], acc[ai][bj][m][n], 0, 0, 0); __builtin_amdgcn_s_setprio(0); } while (0)
#define PG8_WAIT_V(n) asm volatile("s_waitcnt vmcnt(" #n ")" ::: "memory")
#define PG8_WAIT_L(n) asm volatile("s_waitcnt lgkmcnt(" #n ")" ::: "memory")
#define PG8_BAR __builtin_amdgcn_s_barrier()
#define PG8_SCHED __builtin_amdgcn_sched_barrier(0)
    Unit cur, nxt; int ui = 0;
    if (!S.next(0, cur)) return;
    f32x4 acc[2][2][4][2];
#pragma unroll
    for (int a = 0; a < 2; ++a)
#pragma unroll
        for (int b = 0; b < 2; ++b)
#pragma unroll
            for (int m = 0; m < 4; ++m)
#pragma unroll
                for (int n = 0; n < 2; ++n) acc[a][b][m][n] = (f32x4){0.f, 0.f, 0.f, 0.f};
    bf16x8 At[4][2], B0[2][2], B1[2][2];
    const char* cA = (const char*)g.A + (size_t)cur.pm * tstep; const char* cB = (const char*)g.Bt + (size_t)cur.pn * tstep;
    S.a_ready(cur);
    if constexpr (SP2) {
        PG8_STAGE(PG8_SB(0, 0), cB, voffB); PG8_STAGE(PG8_SB(0, 1), cB + hstep, voffB); PG8_STAGE(PG8_SA(0, 0), cA, voffA); PG8_STAGE(PG8_SA(0, 1), cA + hstep, voffA);
        if (wr == 1) PG8_BAR;
        PG8_WAIT_V(2); PG8_BAR;
        PG8_STAGE(PG8_SB(1, 0), cB + kstep, voffB); PG8_STAGE(PG8_SA(1, 0), cA + kstep, voffA); PG8_STAGE(PG8_SB(1, 1), cB + hstep + kstep, voffB);
        PG8_WAIT_V(6); PG8_BAR;
    } else {
        PG8_STAGE(PG8_SB(0, 0), cB, voffB); PG8_STAGE(PG8_SA(0, 0), cA, voffA); PG8_STAGE(PG8_SB(0, 1), cB + hstep, voffB); PG8_STAGE(PG8_SA(0, 1), cA + hstep, voffA);
        if (wr == 1) PG8_BAR;
        PG8_WAIT_V(4); PG8_BAR;
        PG8_STAGE(PG8_SB(1, 0), cB + kstep, voffB); PG8_STAGE(PG8_SA(1, 0), cA + kstep, voffA); PG8_STAGE(PG8_SB(1, 1), cB + hstep + kstep, voffB);
        PG8_WAIT_V(6); PG8_BAR;
    }
    for (;;) {
        const bool has_next = S.next(ui + 1, nxt);
        const char* nA = has_next ? (const char*)g.A + (size_t)nxt.pm * tstep : cA; const char* nB = has_next ? (const char*)g.Bt + (size_t)nxt.pn * tstep : cB;
        for (int t = 0; t < nt; t += 2) {
            const bool last = (t == nt - 2);
            const char* a1 = cA + (size_t)(t + 1) * kstep;
            const char* a2 = last ? nA : cA + (size_t)(t + 2) * kstep; const char* b2 = last ? nB : cB + (size_t)(t + 2) * kstep;
            const char* a3 = a2 + kstep; const char* b3 = b2 + kstep;
            if (last && has_next) S.a_ready(nxt);
            if constexpr (SP2) {
            PG8_LDB(B0, 0, 0); PG8_LDB(B1, 0, 1); PG8_SCHED; PG8_LDA(At, 0, 0); PG8_STAGE(PG8_SA(1, 1), a1 + hstep, voffA);
            PG8_WAIT_V(8); PG8_WAIT_L(0); PG8_BAR; PG8_MMA(0, 0, At, B0); PG8_MMA(0, 1, At, B1); PG8_BAR; PG8_SCHED;
            PG8_LDA(At, 0, 1); PG8_STAGE(PG8_SB(0, 0), b2, voffB); PG8_STAGE(PG8_SB(0, 1), b2 + hstep, voffB); PG8_STAGE(PG8_SA(0, 0), a2, voffA);
            PG8_WAIT_V(8); PG8_WAIT_L(0); PG8_BAR; PG8_MMA(1, 0, At, B0); PG8_MMA(1, 1, At, B1); PG8_BAR; PG8_SCHED;
            PG8_LDB(B0, 1, 0); PG8_LDB(B1, 1, 1); PG8_SCHED; PG8_LDA(At, 1, 0); PG8_STAGE(PG8_SA(0, 1), a2 + hstep, voffA);
            PG8_WAIT_V(8); PG8_WAIT_L(0); PG8_BAR; PG8_MMA(0, 0, At, B0); PG8_MMA(0, 1, At, B1); PG8_BAR; PG8_SCHED;
            PG8_LDA(At, 1, 1); PG8_STAGE(PG8_SB(1, 0), b3, voffB); PG8_STAGE(PG8_SB(1, 1), b3 + hstep, voffB); PG8_STAGE(PG8_SA(1, 0), a3, voffA);
            PG8_WAIT_V(8); PG8_WAIT_L(0); PG8_BAR; PG8_MMA(1, 0, At, B0); PG8_MMA(1, 1, At, B1); PG8_BAR; PG8_SCHED;
            } else {
            PG8_LDB(B0, 0, 0); PG8_SCHED; PG8_LDA(At, 0, 0); PG8_STAGE(PG8_SA(1, 1), a1 + hstep, voffA);
            PG8_WAIT_L(8); PG8_BAR; PG8_WAIT_L(0); PG8_MMA(0, 0, At, B0); PG8_BAR; PG8_SCHED;
            PG8_LDB(B1, 0, 1); PG8_STAGE(PG8_SB(0, 0), b2, voffB);
            PG8_BAR; PG8_WAIT_L(0); PG8_MMA(0, 1, At, B1); PG8_BAR;
            PG8_LDA(At, 0, 1); PG8_STAGE(PG8_SA(0, 0), a2, voffA);
            PG8_BAR; PG8_WAIT_L(0); PG8_MMA(1, 0, At, B0); PG8_BAR; PG8_SCHED;
            PG8_STAGE(PG8_SB(0, 1), b2 + hstep, voffB);
            PG8_WAIT_V(6); PG8_BAR; PG8_MMA(1, 1, At, B1); PG8_BAR;
            PG8_LDB(B0, 1, 0); PG8_SCHED; PG8_LDA(At, 1, 0); PG8_STAGE(PG8_SA(0, 1), a2 + hstep, voffA);
            PG8_WAIT_L(8); PG8_BAR; PG8_WAIT_L(0); PG8_MMA(0, 0, At, B0); PG8_BAR; PG8_SCHED;
            PG8_LDB(B1, 1, 1); PG8_STAGE(PG8_SB(1, 0), b3, voffB);
            PG8_BAR; PG8_WAIT_L(0); PG8_MMA(0, 1, At, B1); PG8_BAR;
            PG8_LDA(At, 1, 1); PG8_STAGE(PG8_SA(1, 0), a3, voffA);
            PG8_BAR; PG8_WAIT_L(0); PG8_MMA(1, 0, At, B0); PG8_BAR; PG8_SCHED;
            PG8_STAGE(PG8_SB(1, 1), b3 + hstep, voffB);
            PG8_WAIT_V(6); PG8_BAR; PG8_MMA(1, 1, At, B1); PG8_BAR;
            }
        }
        if constexpr (ALIGN_EPI) { if (wr == 0) PG8_BAR; }
        if constexpr (!Epi::AFTER_DRAIN) { E(acc, cur, wr, wc, fr, fq); S.done(cur); }
        if (!has_next) break;
#pragma unroll
        for (int a = 0; a < 2; ++a)
#pragma unroll
            for (int b = 0; b < 2; ++b)
#pragma unroll
                for (int m = 0; m < 4; ++m)
#pragma unroll
                    for (int n = 0; n < 2; ++n) acc[a][b][m][n] = (f32x4){0.f, 0.f, 0.f, 0.f};
        cur = nxt; cA = nA; cB = nB; ++ui;
        if constexpr (ALIGN_EPI) { if (wr == 1) PG8_BAR; }
    }
    PG8_WAIT_V(0);
    if constexpr (!ALIGN_EPI) { if (wr == 0) PG8_BAR; }
    PG8_BAR;
    if constexpr (Epi::AFTER_DRAIN) { E.fused(acc, cur, wr, wc, fr, fq, lds, wid, lane); S.done(cur); }
#undef PG8_SA
#undef PG8_SB
#undef PG8_STAGE
#undef PG8_LDA
#undef PG8_LDB
#undef PG8_MMA
#undef PG8_WAIT_V
#undef PG8_WAIT_L
#undef PG8_BAR
#undef PG8_SCHED
}
}
#define GAS __attribute__((address_space(1)))
#define LAS __attribute__((address_space(3)))
typedef unsigned short bf16;
typedef unsigned v4u __attribute__((ext_vector_type(4)));
typedef float f32x4 __attribute__((ext_vector_type(4)));
typedef short bf16x8 __attribute__((ext_vector_type(8)));
typedef GAS unsigned gu32;
typedef GAS unsigned long long gu64;
#define RLX_AGENT __ATOMIC_RELAXED, __HIP_MEMORY_SCOPE_AGENT
#define LDS_WAIT() asm volatile("s_waitcnt lgkmcnt(0)" ::: "memory")
#define VM_WAIT() asm volatile("s_waitcnt vmcnt(0)" ::: "memory")
__device__ __forceinline__ unsigned long long rt() { return __builtin_amdgcn_s_memrealtime(); }
__device__ __forceinline__ unsigned f2bf(float f) { unsigned u = __builtin_bit_cast(unsigned, f); return (u + 0x7fffu + ((u >> 16) & 1u)) >> 16; }
__device__ __forceinline__ unsigned pk2(float lo, float hi) { return f2bf(lo) | (f2bf(hi) << 16); }

#define XB_TMO      128
#define XB_XCNT(j)  (256  + 64 * (j))
#define XB_XSUB(j)  (1280 + 64 * (j))
#define XB_XGEN(j)  (2304 + 64 * (j))
#define XB_TOP      3328
#define XB_TOPGEN   3392
#define XCD_BAR_WORDS 3456
#define XB_SPIN_CAP (1u << 18)

__device__ __forceinline__ unsigned xb_ld(unsigned* p)              { return __hip_atomic_load(p, __ATOMIC_RELAXED, __HIP_MEMORY_SCOPE_AGENT); }
__device__ __forceinline__ unsigned xb_add(unsigned* p, unsigned v) { return __hip_atomic_fetch_add(p, v, __ATOMIC_RELAXED, __HIP_MEMORY_SCOPE_AGENT); }
__device__ __forceinline__ unsigned xb_xcc_id() { return (unsigned)__builtin_amdgcn_s_getreg((3 << 11) | 20) & 0xFu; }
#define XB_SPIN(cond, bar) do { unsigned _sp = 0; while (cond) { __builtin_amdgcn_s_sleep(1); \
    if ((++_sp & 255u) == 0u) { if (xb_ld(&(bar)[XB_TMO])) break; if (_sp > XB_SPIN_CAP) { atomicAdd(&(bar)[XB_TMO], 1u); break; } } } } while (0)

struct XcdBarrier {
    unsigned* bar; unsigned x;
    volatile LAS unsigned* st;
};

__device__ __forceinline__ XcdBarrier xcd_barrier_post(unsigned* bar, volatile LAS unsigned* st) {
    XcdBarrier b; b.bar = bar; b.x = xb_xcc_id(); b.st = st;
    if (threadIdx.x == 0) (void)xb_add(&bar[XB_XCNT(b.x)], 1u);
    return b;
}
__device__ __forceinline__ void xcd_barrier_complete(unsigned* bar, unsigned x, unsigned& nloc, unsigned& nx) {
    const unsigned G = gridDim.x * gridDim.y * gridDim.z;
    unsigned sum, cnt, mine, sp = 0u;
    for (;;) {
        sum = 0u; cnt = 0u; mine = 0u;
#pragma unroll
        for (unsigned j = 0; j < 16; ++j) { const unsigned c = xb_ld(&bar[XB_XCNT(j)]); sum += c; cnt += (c > 0u) ? 1u : 0u; mine = (j == x) ? c : mine; }
        if (sum == G) break;
        __builtin_amdgcn_s_sleep(1);
        if ((++sp & 255u) == 0u) { if (xb_ld(&bar[XB_TMO])) break; if (sp > XB_SPIN_CAP) { atomicAdd(&bar[XB_TMO], 1u); break; } }
    }
    nloc = mine > 0u ? mine : 1u; nx = cnt > 0u ? cnt : 1u;
}

__device__ __forceinline__ void xcd_barrier(const XcdBarrier& b) {
    asm volatile("s_waitcnt vmcnt(0)" ::: "memory");
    __syncthreads();
    if (threadIdx.x == 0) {
        unsigned* bar = b.bar;
        __builtin_amdgcn_s_waitcnt(0);
        unsigned nloc = b.st[0], nx = b.st[1];
        if (nloc == 0u) { xcd_barrier_complete(bar, b.x, nloc, nx); b.st[0] = nloc; b.st[1] = nx; }
        const unsigned old = xb_add(&bar[XB_XSUB(b.x)], 1u);
        const unsigned gen = old / nloc;
        if (old + 1u == (gen + 1u) * nloc) {
            __builtin_amdgcn_fence(__ATOMIC_RELEASE, "agent");
            asm volatile("s_waitcnt vmcnt(0)" ::: "memory");
            const unsigned og = xb_add(&bar[XB_TOP], 1u);
            const unsigned tg = og / nx;
            if (og + 1u == (tg + 1u) * nx) xb_add(&bar[XB_TOPGEN], 1u);
            else XB_SPIN(xb_ld(&bar[XB_TOPGEN]) == tg, bar);
            __builtin_amdgcn_fence(__ATOMIC_ACQUIRE, "agent");
            xb_add(&bar[XB_XGEN(b.x)], 1u);
            asm volatile("s_waitcnt vmcnt(0)" ::: "memory");
        } else {
            XB_SPIN(xb_ld(&bar[XB_XGEN(b.x)]) == gen, bar);
            __builtin_amdgcn_fence(__ATOMIC_ACQUIRE, "agent");
            asm volatile("s_waitcnt vmcnt(0)" ::: "memory");
        }
    }
    __syncthreads();
}

constexpr int NWAVES = 8, NTHREADS = 512;
constexpr int D = 1024, SEQ = 2048, NB = 8, MP = NB * SEQ, DECB = 128, DECS = 4, MS = DECB * DECS, MT = MP + MS;
constexpr int FF = 2816, NGU = 2 * FF, NIN = 3584, NMEM = 256, MM = NB * NMEM;
constexpr int PAST = 2048, PAGE = 128, NPAGES = 16, NPOS = PAST + DECS;
constexpr float EPS = 1e-6f;
constexpr int C_QR = 0, C_KR = 512, C_VR = 1024, C_GR = 1536, C_QS = 2048, C_KS = 2560, C_VS = 3072;
constexpr size_t O_Y = 0, O_RSP = 17301504, O_SBKP = 17825792, O_SBVP = 26214400, O_MKP = 34603008, O_MVP = 36700160, O_RSS = 38797312, O_SBKS = 47185920, O_SBVS = 47448064, O_END = 47710208;
enum { I_XP = 0, I_XS, I_MEM, I_CRET, I_CSBK, I_CSBV, I_CMK, I_CMV, I_PT, I_G1PRE, I_W1G, I_W1U, I_W1D, I_G1POST, I_GMIXPRE, I_WIN, I_BSB, I_GGN, I_WOUT, I_GMIXPOST, I_GMEM, I_WMK, I_WMV, I_GXPRE, I_WXQ, I_WXO, I_GXPOST, I_G2PRE, I_W2G, I_W2U, I_W2D, I_G2POST, N_IN };

constexpr size_t MiB = 1u << 20;
constexpr size_t WS_CTL = 0, CTL_ZERO_BYTES = 1 * MiB;
constexpr size_t WS_ROPE = 1 * MiB;
constexpr size_t WS_WGU1 = 4 * MiB, WS_WD1 = 15 * MiB, WS_WIN = 21 * MiB, WS_WOUT = 28 * MiB, WS_WMKV = 30 * MiB, WS_WXQ = 34 * MiB, WS_WXO = 36 * MiB, WS_WGU2 = 38 * MiB, WS_WD2 = 49 * MiB;
constexpr size_t WS_XN = 64 * MiB, WS_MN = 97 * MiB, WS_CAT = 101 * MiB, WS_OX = 134 * MiB, WS_H = 167 * MiB, WS_C2 = 258 * MiB, WS_C3 = 324 * MiB, WS_C1 = 555 * MiB, WS_OR = 918 * MiB, WS_OS = 951 * MiB, WS_END = 984 * MiB;
static_assert(WS_WD2 + (size_t)D * FF * 2 <= WS_XN && WS_XN + (size_t)MT * D * 2 <= WS_MN && WS_H + (size_t)MT * FF * 2 <= WS_C2 && WS_C2 + (size_t)MT * D * 4 <= WS_C3 && WS_C3 + (size_t)MT * NIN * 4 <= WS_C1 && WS_C1 + (size_t)MT * NGU * 4 <= WS_OR, "ws map");
constexpr int CW_TMO = 0, CW_BAR = 4096;

constexpr int RING_BYTES = 131072, LDSCTL_OFF = RING_BYTES, MISC_OFF = LDSCTL_OFF + 320, LDS_BYTES = 147456;

struct Ctx { LAS unsigned char* lds; int tid, lane, wave, gw, ngw; };
struct Args { const void* in[N_IN]; float* out; unsigned char* ws; int ph_lo, ph_hi; };
static_assert(sizeof(Args) == N_IN * 8 + 8 + 8 + 8, "Args has no padding");

__device__ __forceinline__ float wave_sum(float v) {
#pragma unroll
    for (int o = 1; o < 64; o <<= 1) v += __shfl_xor(v, o);
    return v;
}
__device__ __forceinline__ float wave_max(float v) {
#pragma unroll
    for (int o = 1; o < 64; o <<= 1) v = fmaxf(v, __shfl_xor(v, o));
    return v;
}
__device__ __forceinline__ unsigned long long pk4(f32x4 v) { return (unsigned long long)pk2(v.x, v.y) | ((unsigned long long)pk2(v.z, v.w) << 32); }

__device__ __forceinline__ void p0_transpose_item(const float* W, int K, int N, bf16* WT, int row_off, LAS float* scr, int item, int lane) {
    const int nblk = N / 32, kb = item / nblk, nb = item % nblk, k0 = 64 * kb, n0 = 32 * nb;
#pragma unroll 8
    for (int i = 0; i < 32; ++i) { const int kk = 2 * i + (lane >> 5); scr[kk * 33 + (lane & 31)] = W[(size_t)(k0 + kk) * N + n0 + (lane & 31)]; }
    LDS_WAIT(); asm volatile("" ::: "memory");
    const int c = lane & 7;
#pragma unroll
    for (int j = 0; j < 4; ++j) { const int n = (lane >> 3) + 8 * j; const LAS float* s = scr + (8 * c) * 33 + n;
        v4u o; o.x = pk2(s[0 * 33], s[1 * 33]); o.y = pk2(s[2 * 33], s[3 * 33]); o.z = pk2(s[4 * 33], s[5 * 33]); o.w = pk2(s[6 * 33], s[7 * 33]);
        *(GAS v4u*)(WT + (size_t)(row_off + n0 + n) * K + k0 + 8 * c) = o; }
    LDS_WAIT(); asm volatile("" ::: "memory");
}
__device__ __forceinline__ void rms_row_to_bf16(const float* xrow, const float* g, bf16* orow, int lane) {
    const f32x4* xr = (const f32x4*)xrow + lane; const f32x4* gr = (const f32x4*)g + lane;
    f32x4 v[4]; float s = 0.f;
#pragma unroll
    for (int j = 0; j < 4; ++j) { v[j] = xr[64 * j]; s += (v[j].x * v[j].x + v[j].y * v[j].y) + (v[j].z * v[j].z + v[j].w * v[j].w); }
    const float rstd = 1.0f / sqrtf(wave_sum(s) * (1.f / D) + EPS);
    unsigned long long* o8 = (unsigned long long*)orow + lane;
#pragma unroll
    for (int j = 0; j < 4; ++j) { const f32x4 gg = gr[64 * j]; o8[64 * j] = pk4(v[j] * rstd * gg); }
}
__device__ __forceinline__ void sincos_d(double a, double& s, double& c) {
    const double TWO_OVER_PI = 0.63661977236758134308, PIO2_HI = 1.57079632679489655800e+00, PIO2_LO = 6.12323399573676603587e-17;
    const double kf = rint(a * TWO_OVER_PI); const int k = (int)kf;
    const double r = (a - kf * PIO2_HI) - kf * PIO2_LO, r2 = r * r;
    double sp = -1.0 / 1307674368000.0; sp = sp * r2 + 1.0 / 6227020800.0; sp = sp * r2 - 1.0 / 39916800.0; sp = sp * r2 + 1.0 / 362880.0; sp = sp * r2 - 1.0 / 5040.0; sp = sp * r2 + 1.0 / 120.0; sp = sp * r2 - 1.0 / 6.0; sp = sp * r2 * r + r;
    double cp = 1.0 / 20922789888000.0; cp = cp * r2 - 1.0 / 87178291200.0; cp = cp * r2 + 1.0 / 479001600.0; cp = cp * r2 - 1.0 / 3628800.0; cp = cp * r2 + 1.0 / 40320.0; cp = cp * r2 - 1.0 / 720.0; cp = cp * r2 + 1.0 / 24.0; cp = cp * r2 - 0.5; cp = cp * r2 + 1.0;
    switch (k & 3) { case 0: s = sp; c = cp; break; case 1: s = cp; c = -sp; break; case 2: s = -sp; c = -cp; break; default: s = -cp; c = sp; break; }
}

__device__ __forceinline__ void ph_prologue(const Ctx& c, const Args& a) {
    LAS float* scr = (LAS float*)(c.lds + c.wave * 16384);
    unsigned char* ws = a.ws;
    constexpr int I_G = (D / 64) * (FF / 32), I_DN = (FF / 64) * (D / 32), I_INP = (D / 64) * (NIN / 32), I_SQ = (D / 64) * (D / 32);
    constexpr int NITEMS = 4 * I_G + 2 * I_DN + I_INP + 5 * I_SQ;
    for (int it = c.gw; it < NITEMS; it += c.ngw) {
        int r = it;
        if (r < I_G) { p0_transpose_item((const float*)a.in[I_W1G], D, FF, (bf16*)(ws + WS_WGU1), 0, scr, r, c.lane); continue; } r -= I_G;
        if (r < I_G) { p0_transpose_item((const float*)a.in[I_W1U], D, FF, (bf16*)(ws + WS_WGU1), FF, scr, r, c.lane); continue; } r -= I_G;
        if (r < I_G) { p0_transpose_item((const float*)a.in[I_W2G], D, FF, (bf16*)(ws + WS_WGU2), 0, scr, r, c.lane); continue; } r -= I_G;
        if (r < I_G) { p0_transpose_item((const float*)a.in[I_W2U], D, FF, (bf16*)(ws + WS_WGU2), FF, scr, r, c.lane); continue; } r -= I_G;
        if (r < I_DN) { p0_transpose_item((const float*)a.in[I_W1D], FF, D, (bf16*)(ws + WS_WD1), 0, scr, r, c.lane); continue; } r -= I_DN;
        if (r < I_DN) { p0_transpose_item((const float*)a.in[I_W2D], FF, D, (bf16*)(ws + WS_WD2), 0, scr, r, c.lane); continue; } r -= I_DN;
        if (r < I_INP) { p0_transpose_item((const float*)a.in[I_WIN], D, NIN, (bf16*)(ws + WS_WIN), 0, scr, r, c.lane); continue; } r -= I_INP;
        if (r < I_SQ) { p0_transpose_item((const float*)a.in[I_WOUT], D, D, (bf16*)(ws + WS_WOUT), 0, scr, r, c.lane); continue; } r -= I_SQ;
        if (r < I_SQ) { p0_transpose_item((const float*)a.in[I_WMK], D, D, (bf16*)(ws + WS_WMKV), 0, scr, r, c.lane); continue; } r -= I_SQ;
        if (r < I_SQ) { p0_transpose_item((const float*)a.in[I_WMV], D, D, (bf16*)(ws + WS_WMKV), D, scr, r, c.lane); continue; } r -= I_SQ;
        if (r < I_SQ) { p0_transpose_item((const float*)a.in[I_WXQ], D, D, (bf16*)(ws + WS_WXQ), 0, scr, r, c.lane); continue; } r -= I_SQ;
        p0_transpose_item((const float*)a.in[I_WXO], D, D, (bf16*)(ws + WS_WXO), 0, scr, r, c.lane);
    }
    float2* rope = (float2*)(ws + WS_ROPE);
    for (int idx = c.gw * 64 + c.lane; idx < NPOS * 64; idx += c.ngw * 64) {
        const int pos = idx >> 6, i = idx & 63;
        double inv = 1.0; for (int k = 0; k < i; ++k) inv *= 0.8659643233600653;
        double s, co; sincos_d((double)pos * inv, s, co);
        rope[idx] = make_float2((float)co, (float)s);
    }
    for (int m = c.gw; m < MT; m += c.ngw) {
        const float* src = m < MP ? (const float*)a.in[I_XP] + (size_t)m * D : (const float*)a.in[I_XS] + (size_t)(m - MP) * D;
        rms_row_to_bf16(src, (const float*)a.in[I_G1PRE], (bf16*)(ws + WS_XN) + (size_t)m * D, c.lane);
    }
    for (int m = c.gw; m < MM; m += c.ngw)
        rms_row_to_bf16((const float*)a.in[I_MEM] + (size_t)m * D, (const float*)a.in[I_GMEM], (bf16*)(ws + WS_MN) + (size_t)m * D, c.lane);
}

__device__ __forceinline__ void ph_swiglu(const Ctx& c, const float* C1, bf16* H) {
    constexpr int Q = FF / 4;
    const size_t total = (size_t)MT * Q;
    for (size_t idx = (size_t)blockIdx.x * NTHREADS + c.tid; idx < total; idx += (size_t)gridDim.x * NTHREADS) {
        const int r = (int)(idx / Q), q = (int)(idx % Q);
        const f32x4 g = *(const f32x4*)(C1 + (size_t)r * NGU + 4 * q), u = *(const f32x4*)(C1 + (size_t)r * NGU + FF + 4 * q);
        f32x4 h; h.x = g.x / (1.f + expf(-g.x)) * u.x; h.y = g.y / (1.f + expf(-g.y)) * u.y; h.z = g.z / (1.f + expf(-g.z)) * u.z; h.w = g.w / (1.f + expf(-g.w)) * u.w;
        *(unsigned long long*)(H + (size_t)r * FF + 4 * q) = pk4(h);
    }
}

template <bool FIRST, bool FINAL>
__device__ __forceinline__ void ph_post(const Ctx& c, const Args& a, const float* C2, float scale, const float* gpost, const float* gpre) {
    float* hout = a.out + O_Y; bf16* XN = (bf16*)(a.ws + WS_XN);
    for (int m = c.gw; m < MT; m += c.ngw) {
        const float* base = FIRST ? (m < MP ? (const float*)a.in[I_XP] + (size_t)m * D : (const float*)a.in[I_XS] + (size_t)(m - MP) * D) : hout + (size_t)m * D;
        const f32x4* cr = (const f32x4*)(C2 + (size_t)m * D) + c.lane; const f32x4* br = (const f32x4*)base + c.lane; const f32x4* g1 = (const f32x4*)gpost + c.lane;
        f32x4 v[4]; float s = 0.f;
#pragma unroll
        for (int j = 0; j < 4; ++j) { v[j] = cr[64 * j]; s += (v[j].x * v[j].x + v[j].y * v[j].y) + (v[j].z * v[j].z + v[j].w * v[j].w); }
        const float rstd = scale / sqrtf(wave_sum(s) * (1.f / D) + EPS);
        float s2 = 0.f;
#pragma unroll
        for (int j = 0; j < 4; ++j) { v[j] = br[64 * j] + v[j] * rstd * g1[64 * j]; s2 += (v[j].x * v[j].x + v[j].y * v[j].y) + (v[j].z * v[j].z + v[j].w * v[j].w); }
        f32x4* ho = (f32x4*)(hout + (size_t)m * D) + c.lane;
#pragma unroll
        for (int j = 0; j < 4; ++j) ho[64 * j] = v[j];
        if (!FINAL) {
            const float rstd2 = 1.0f / sqrtf(wave_sum(s2) * (1.f / D) + EPS);
            const f32x4* g2 = (const f32x4*)gpre + c.lane; unsigned long long* o8 = (unsigned long long*)(XN + (size_t)m * D) + c.lane;
#pragma unroll
            for (int j = 0; j < 4; ++j) o8[64 * j] = pk4(v[j] * rstd2 * g2[64 * j]);
        }
    }
}

__device__ __forceinline__ void ph_inproj_post(const Ctx& c, const Args& a) {
    float* C3 = (float*)(a.ws + WS_C3); const float2* rope = (const float2*)(a.ws + WS_ROPE);
    for (int r = c.gw; r < MT; r += c.ngw) {
        const int pos = r < MP ? (r & (SEQ - 1)) : PAST + ((r - MP) & (DECS - 1));
        float* row = C3 + (size_t)r * NIN;
        const float2 cs = rope[pos * 64 + c.lane];
#pragma unroll
        for (int h = 0; h < 4; ++h) {
            { float* p = row + C_QR + h * 128 + c.lane; const float x1 = p[0], x2 = p[64]; p[0] = x1 * cs.x - x2 * cs.y; p[64] = x1 * cs.y + x2 * cs.x; }
            { float* p = row + C_KR + h * 128 + c.lane; const float x1 = p[0], x2 = p[64]; p[0] = (x1 * cs.x - x2 * cs.y) * 0.08838834764831845f; p[64] = (x1 * cs.y + x2 * cs.x) * 0.08838834764831845f; }
        }
        float* dk = r < MP ? a.out + O_SBKP + (size_t)r * 512 : a.out + O_SBKS + (size_t)(r - MP) * 512;
        float* dv = r < MP ? a.out + O_SBVP + (size_t)r * 512 : a.out + O_SBVS + (size_t)(r - MP) * 512;
#pragma unroll
        for (int j = 0; j < 2; ++j) { ((f32x4*)dk)[c.lane + 64 * j] = ((const f32x4*)(row + C_KS))[c.lane + 64 * j]; ((f32x4*)dv)[c.lane + 64 * j] = ((const f32x4*)(row + C_VS))[c.lane + 64 * j]; }
    }
}

__device__ __forceinline__ void ph_ret_naive(const Ctx& c, const Args& a) {
    constexpr int TB = 16;
    const float* C3 = (const float*)(a.ws + WS_C3); float* OR = (float*)(a.ws + WS_OR);
    const int g = c.tid >> 7, e = c.tid & 127; const int bid = blockIdx.x;
    LAS float* qk = (LAS float*)c.lds + g * (TB * 256);
    if (bid < 8) {
        const int item = bid * 4 + g, b = item >> 2, h = item & 3;
        const float gamma = 1.0f - exp2f(-5.0f - (float)h);
        float S[128];
#pragma unroll
        for (int d = 0; d < 128; ++d) S[d] = 0.f;
        for (int t0 = 0; t0 < SEQ; t0 += TB) {
            for (int i = e; i < TB * 256; i += 128) { const int tok = i >> 8, cc = i & 255; const float* rowp = C3 + (size_t)(b * SEQ + t0 + tok) * NIN;
                qk[i] = cc < 128 ? rowp[C_QR + h * 128 + cc] : rowp[C_KR + h * 128 + (cc - 128)]; }
            __syncthreads();
            for (int tok = 0; tok < TB; ++tok) {
                const size_t row = (size_t)(b * SEQ + t0 + tok);
                const float v = C3[row * NIN + C_VR + h * 128 + e];
                const LAS float* qq = qk + tok * 256; float o = 0.f;
#pragma unroll
                for (int d = 0; d < 128; ++d) { S[d] = gamma * S[d] + qq[128 + d] * v; o += qq[d] * S[d]; }
                OR[row * 512 + h * 128 + e] = o;
            }
            __syncthreads();
        }
        float* so = a.out + O_RSP + (size_t)item * 16384 + e;
#pragma unroll
        for (int d = 0; d < 128; ++d) so[d * 128] = S[d];
    } else if (bid < 8 + DECB) {
        const int item = (bid - 8) * 4 + g, b = item >> 2, h = item & 3;
        const float gamma = 1.0f - exp2f(-5.0f - (float)h);
        const float* s0 = (const float*)a.in[I_CRET] + (size_t)item * 16384 + e;
        float S[128];
#pragma unroll
        for (int d = 0; d < 128; ++d) S[d] = s0[d * 128];
        for (int i = e; i < DECS * 256; i += 128) { const int tok = i >> 8, cc = i & 255; const float* rowp = C3 + (size_t)(MP + b * DECS + tok) * NIN;
            qk[i] = cc < 128 ? rowp[C_QR + h * 128 + cc] : rowp[C_KR + h * 128 + (cc - 128)]; }
        __syncthreads();
        for (int tok = 0; tok < DECS; ++tok) {
            const size_t row = (size_t)(MP + b * DECS + tok);
            const float v = C3[row * NIN + C_VR + h * 128 + e];
            const LAS float* qq = qk + tok * 256; float o = 0.f;
#pragma unroll
            for (int d = 0; d < 128; ++d) { S[d] = gamma * S[d] + qq[128 + d] * v; o += qq[d] * S[d]; }
            OR[row * 512 + h * 128 + e] = o;
        }
        float* so = a.out + O_RSS + (size_t)item * 16384 + e;
#pragma unroll
        for (int d = 0; d < 128; ++d) so[d * 128] = S[d];
        __syncthreads();
    }
}

__device__ __forceinline__ void ph_sb_naive(const Ctx& c, const Args& a) {
    const float* C3 = (const float*)(a.ws + WS_C3); float* OS = (float*)(a.ws + WS_OS);
    const float* ck = (const float*)a.in[I_CSBK]; const float* cv = (const float*)a.in[I_CSBV]; const int* pt = (const int*)a.in[I_PT];
    constexpr int NPI = NB * 8 * SEQ, NSI = DECB * 8 * DECS;
    const int lane = c.lane;
    for (int it = c.gw; it < NPI + NSI; it += c.ngw) {
        int t, h, b, qrow; const bool smp = it >= NPI;
        if (!smp) { t = it & (SEQ - 1); h = (it >> 11) & 7; b = it >> 14; qrow = b * SEQ + t; }
        else { const int j = it - NPI; const int i = j & 3; h = (j >> 2) & 7; b = j >> 5; t = PAST + i; qrow = MP + b * DECS + i; }
        const float bias = ((const float*)a.in[I_BSB])[h];
        const f32x4* qp = (const f32x4*)(C3 + (size_t)qrow * NIN + C_QS + h * 64);
        f32x4 q[16], acc[16];
#pragma unroll
        for (int i = 0; i < 16; ++i) { q[i] = qp[i]; acc[i] = (f32x4){0.f, 0.f, 0.f, 0.f}; }
        float carry = 0.f;
        for (int s0 = t - 1; s0 >= 0; s0 -= 64) {
            const int s = s0 - lane; const bool valid = s >= 0;
            const float* kp = C3 + C_KS + h * 64; const float* vp = C3 + C_VS + h * 64;
            if (valid) {
                if (!smp) { kp = C3 + (size_t)(b * SEQ + s) * NIN + C_KS + h * 64; vp = kp + (C_VS - C_KS); }
                else if (s >= PAST) { kp = C3 + (size_t)(MP + b * DECS + (s - PAST)) * NIN + C_KS + h * 64; vp = kp + (C_VS - C_KS); }
                else { const int pg = pt[b * NPAGES + (s >> 7)]; const size_t off = ((size_t)pg * PAGE + (s & (PAGE - 1))) * 512 + h * 64; kp = ck + off; vp = cv + off; }
            }
            float z = 0.f;
#pragma unroll
            for (int i = 0; i < 16; ++i) { const f32x4 kk = ((const f32x4*)kp)[i]; z += (q[i].x * kk.x + q[i].y * kk.y) + (q[i].z * kk.z + q[i].w * kk.w); }
            z = z * 0.125f + bias;
            const float sp = fmaxf(z, 0.f) + log1pf(expf(-fabsf(z)));
            const float lsn = valid ? -sp : 0.f;
            float inc = lsn;
#pragma unroll
            for (int o = 1; o < 64; o <<= 1) { const float y = __shfl_up(inc, o); if (lane >= o) inc += y; }
            const float later = carry + (inc - lsn);
            const float av = valid ? expf((z - sp) + later) : 0.f;
            carry += __shfl(inc, 63);
#pragma unroll
            for (int i = 0; i < 16; ++i) { const f32x4 vv = ((const f32x4*)vp)[i]; acc[i] += av * vv; }
        }
        float outv = 0.f;
#pragma unroll
        for (int i = 0; i < 16; ++i) {
            const float r0 = wave_sum(acc[i].x), r1 = wave_sum(acc[i].y), r2 = wave_sum(acc[i].z), r3 = wave_sum(acc[i].w);
            if (lane == 4 * i) outv = r0; if (lane == 4 * i + 1) outv = r1; if (lane == 4 * i + 2) outv = r2; if (lane == 4 * i + 3) outv = r3;
        }
        OS[(size_t)qrow * 512 + h * 64 + lane] = outv;
    }
}

__device__ __forceinline__ void ph_mixout(const Ctx& c, const Args& a) {
    const float* C3 = (const float*)(a.ws + WS_C3); const float* OR = (const float*)(a.ws + WS_OR); const float* OS = (const float*)(a.ws + WS_OS); bf16* CAT = (bf16*)(a.ws + WS_CAT);
    const float* ggn = (const float*)a.in[I_GGN];
    for (int r = c.gw; r < MT; r += c.ngw) {
        const int col = 8 * c.lane;
        const f32x4 x0 = *(const f32x4*)(OR + (size_t)r * 512 + col), x1 = *(const f32x4*)(OR + (size_t)r * 512 + col + 4);
        float s = (x0.x + x0.y) + (x0.z + x0.w) + (x1.x + x1.y) + (x1.z + x1.w);
        s += __shfl_xor(s, 1); s += __shfl_xor(s, 2); s += __shfl_xor(s, 4); s += __shfl_xor(s, 8);
        const float mu = s * (1.f / 128.f);
        const f32x4 d0 = x0 - mu, d1 = x1 - mu;
        float q = (d0.x * d0.x + d0.y * d0.y) + (d0.z * d0.z + d0.w * d0.w) + (d1.x * d1.x + d1.y * d1.y) + (d1.z * d1.z + d1.w * d1.w);
        q += __shfl_xor(q, 1); q += __shfl_xor(q, 2); q += __shfl_xor(q, 4); q += __shfl_xor(q, 8);
        const float rstd = 1.0f / sqrtf(q * (1.f / 128.f) + EPS);
        const f32x4 g0 = *(const f32x4*)(ggn + col), g1 = *(const f32x4*)(ggn + col + 4);
        const f32x4 r0 = *(const f32x4*)(C3 + (size_t)r * NIN + C_GR + col), r1 = *(const f32x4*)(C3 + (size_t)r * NIN + C_GR + col + 4);
        f32x4 y0, y1;
        y0.x = d0.x * rstd * g0.x * (r0.x / (1.f + expf(-r0.x))); y0.y = d0.y * rstd * g0.y * (r0.y / (1.f + expf(-r0.y))); y0.z = d0.z * rstd * g0.z * (r0.z / (1.f + expf(-r0.z))); y0.w = d0.w * rstd * g0.w * (r0.w / (1.f + expf(-r0.w)));
        y1.x = d1.x * rstd * g1.x * (r1.x / (1.f + expf(-r1.x))); y1.y = d1.y * rstd * g1.y * (r1.y / (1.f + expf(-r1.y))); y1.z = d1.z * rstd * g1.z * (r1.z / (1.f + expf(-r1.z))); y1.w = d1.w * rstd * g1.w * (r1.w / (1.f + expf(-r1.w)));
        unsigned long long* o = (unsigned long long*)(CAT + (size_t)r * D + col); o[0] = pk4(y0); o[1] = pk4(y1);
        const f32x4 s0 = *(const f32x4*)(OS + (size_t)r * 512 + col), s1 = *(const f32x4*)(OS + (size_t)r * 512 + col + 4);
        unsigned long long* o2 = (unsigned long long*)(CAT + (size_t)r * D + 512 + col); o2[0] = pk4(s0); o2[1] = pk4(s1);
    }
}

__device__ __forceinline__ void ph_cross_naive(const Ctx& c, const Args& a) {
    const float* QX = (const float*)(a.ws + WS_C2); bf16* OX = (bf16*)(a.ws + WS_OX);
    LAS float* qs = (LAS float*)(c.lds + c.wave * 2048); LAS float* ps = qs + 256;
    const int lane = c.lane;
    for (int it = c.gw; it < MT * 4; it += c.ngw) {
        const int r = it >> 2, h = it & 3;
        const float* Kb; const float* Vb;
        if (r < MP) { const int b = r >> 11; Kb = a.out + O_MKP + (size_t)b * NMEM * D; Vb = a.out + O_MVP + (size_t)b * NMEM * D; }
        else { const int b = (r - MP) >> 2; Kb = (const float*)a.in[I_CMK] + (size_t)b * NMEM * D; Vb = (const float*)a.in[I_CMV] + (size_t)b * NMEM * D; }
        *(LAS f32x4*)(qs + 4 * lane) = *(const f32x4*)(QX + (size_t)r * D + h * 256 + 4 * lane);
        LDS_WAIT(); asm volatile("" ::: "memory");
        float sc[4];
#pragma unroll
        for (int j = 0; j < 4; ++j) { const int m = lane + 64 * j; const f32x4* kp = (const f32x4*)(Kb + (size_t)m * D + h * 256); float s = 0.f;
#pragma unroll 8
            for (int d4 = 0; d4 < 64; ++d4) { const f32x4 kk = kp[d4]; const f32x4 qq = *(const LAS f32x4*)(qs + 4 * d4); s += (kk.x * qq.x + kk.y * qq.y) + (kk.z * qq.z + kk.w * qq.w); }
            sc[j] = s * 0.0625f; }
        const float mx = wave_max(fmaxf(fmaxf(sc[0], sc[1]), fmaxf(sc[2], sc[3])));
        float p[4], sum = 0.f;
#pragma unroll
        for (int j = 0; j < 4; ++j) { p[j] = expf(sc[j] - mx); sum += p[j]; }
        const float inv = 1.0f / wave_sum(sum);
#pragma unroll
        for (int j = 0; j < 4; ++j) ps[lane + 64 * j] = p[j] * inv;
        LDS_WAIT(); asm volatile("" ::: "memory");
        f32x4 o = (f32x4){0.f, 0.f, 0.f, 0.f};
#pragma unroll 8
        for (int m = 0; m < NMEM; ++m) { const float pm = ps[m]; const f32x4 vv = *(const f32x4*)(Vb + (size_t)m * D + h * 256 + 4 * lane); o += pm * vv; }
        *(unsigned long long*)(OX + (size_t)r * D + h * 256 + 4 * lane) = pk4(o);
        LDS_WAIT(); asm volatile("" ::: "memory");
    }
}

__device__ __forceinline__ void ph_gemm_f32(const Ctx& c, const bf16* A, const bf16* Bt, int M, int N, int K, float* C, int ldc, int split_cols, size_t split_stride, int cid) {
    pg8::Gemm g{A, Bt, M, N, K}; pg8::StaticOrder S; S.init(M, N, (int)gridDim.x, cid);
    pg8::EpiF32 E{C, ldc, split_cols, split_stride};
    pg8::gemm_phase<pg8::EpiF32, pg8::StaticOrder, true, true>(c.lds, g, S, E);
}

constexpr int NPH = 19;
__global__ void __launch_bounds__(NTHREADS, 2) fwd(Args args) {
    extern __shared__ __attribute__((aligned(16))) unsigned char lds_raw[];
    Ctx c; c.lds = (LAS unsigned char*)lds_raw; c.tid = threadIdx.x; c.lane = c.tid & 63; c.wave = __builtin_amdgcn_readfirstlane(c.tid >> 6);
    c.gw = blockIdx.x * NWAVES + c.wave; c.ngw = gridDim.x * NWAVES;
    volatile LAS unsigned* MISC = (volatile LAS unsigned*)(c.lds + MISC_OFF);
    for (int u = c.tid; u < (LDS_BYTES - LDSCTL_OFF) / 4; u += NTHREADS) ((LAS unsigned*)(c.lds + LDSCTL_OFF))[u] = 0u;
    __syncthreads();
    unsigned char* ws = args.ws;
    const int lo = args.ph_lo, hi = args.ph_hi;
    const bool multi = (hi - lo) > 1;
    XcdBarrier bar; bar.bar = (unsigned*)(ws + WS_CTL) + CW_BAR; bar.x = 0; bar.st = nullptr;
    if (multi) bar = xcd_barrier_post((unsigned*)(ws + WS_CTL) + CW_BAR, MISC + 8);
#define IN(k) (lo <= (k) && (k) < hi)
#define SEAM(k) do { if (IN(k) && IN((k) + 1)) xcd_barrier(bar); } while (0)
    bf16* XN = (bf16*)(ws + WS_XN); bf16* H = (bf16*)(ws + WS_H); float* C1 = (float*)(ws + WS_C1); float* C2 = (float*)(ws + WS_C2); float* C3 = (float*)(ws + WS_C3);
    const int cid = (int)blockIdx.x;

    if (IN(0)) { ph_prologue(c, args); } SEAM(0);
    if (IN(1)) { ph_gemm_f32(c, XN, (const bf16*)(ws + WS_WGU1), MT, NGU, D, C1, NGU, 0, 0, cid);
                 ph_gemm_f32(c, (const bf16*)(ws + WS_MN), (const bf16*)(ws + WS_WMKV), MM, 2 * D, D, args.out + O_MKP, D, D, (size_t)(O_MVP - O_MKP), (cid + 84) & 255); } SEAM(1);
    if (IN(2)) { ph_swiglu(c, C1, H); } SEAM(2);
    if (IN(3)) { ph_gemm_f32(c, H, (const bf16*)(ws + WS_WD1), MT, D, FF, C2, D, 0, 0, cid); } SEAM(3);
    if (IN(4)) { ph_post<true, false>(c, args, C2, 0.5f, (const float*)args.in[I_G1POST], (const float*)args.in[I_GMIXPRE]); } SEAM(4);
    if (IN(5)) { ph_gemm_f32(c, XN, (const bf16*)(ws + WS_WIN), MT, NIN, D, C3, NIN, 0, 0, cid); } SEAM(5);
    if (IN(6)) { ph_inproj_post(c, args); } SEAM(6);
    if (IN(7)) { ph_ret_naive(c, args); ph_sb_naive(c, args); } SEAM(7);
    if (IN(8)) { ph_mixout(c, args); } SEAM(8);
    if (IN(9)) { ph_gemm_f32(c, (const bf16*)(ws + WS_CAT), (const bf16*)(ws + WS_WOUT), MT, D, D, C2, D, 0, 0, cid); } SEAM(9);
    if (IN(10)) { ph_post<false, false>(c, args, C2, 1.0f, (const float*)args.in[I_GMIXPOST], (const float*)args.in[I_GXPRE]); } SEAM(10);
    if (IN(11)) { ph_gemm_f32(c, XN, (const bf16*)(ws + WS_WXQ), MT, D, D, C2, D, 0, 0, cid); } SEAM(11);
    if (IN(12)) { ph_cross_naive(c, args); } SEAM(12);
    if (IN(13)) { ph_gemm_f32(c, (const bf16*)(ws + WS_OX), (const bf16*)(ws + WS_WXO), MT, D, D, C2, D, 0, 0, cid); } SEAM(13);
    if (IN(14)) { ph_post<false, false>(c, args, C2, 1.0f, (const float*)args.in[I_GXPOST], (const float*)args.in[I_G2PRE]); } SEAM(14);
    if (IN(15)) { ph_gemm_f32(c, XN, (const bf16*)(ws + WS_WGU2), MT, NGU, D, C1, NGU, 0, 0, cid); } SEAM(15);
    if (IN(16)) { ph_swiglu(c, C1, H); } SEAM(16);
    if (IN(17)) { ph_gemm_f32(c, H, (const bf16*)(ws + WS_WD2), MT, D, FF, C2, D, 0, 0, cid); } SEAM(17);
    if (IN(18)) { ph_post<false, true>(c, args, C2, 0.5f, (const float*)args.in[I_G2POST], nullptr); }
#undef IN
#undef SEAM
}

#ifndef MK_ONE_LAUNCH
#define MK_ONE_LAUNCH 1
#endif
extern "C" void kernel_launch(void* const* d_in, const int* in_sizes, int n_in, void* d_out, int out_size, void* d_ws, size_t ws_size, hipStream_t stream) {
    static int grid = 0;
    if (grid == 0) {
        if (n_in != N_IN || (size_t)out_size != O_END || ws_size < WS_END) { fprintf(stderr, "kernel_launch: unexpected shapes: n_in %d out %d ws %zu; nothing launched\n", n_in, out_size, ws_size); grid = -1; return; }
        int dev = 0, cus = 0, per_cu = 0;
        if (hipGetDevice(&dev) != hipSuccess || hipDeviceGetAttribute(&cus, hipDeviceAttributeMultiprocessorCount, dev) != hipSuccess) { grid = -1; return; }
        if (hipFuncSetAttribute((const void*)fwd, hipFuncAttributeMaxDynamicSharedMemorySize, LDS_BYTES) != hipSuccess) { fprintf(stderr, "kernel_launch: hipFuncSetAttribute failed\n"); grid = -1; return; }
        if (hipOccupancyMaxActiveBlocksPerMultiprocessor(&per_cu, (const void*)fwd, NTHREADS, LDS_BYTES) != hipSuccess || per_cu < 1) fprintf(stderr, "kernel_launch: occupancy query reports %d\n", per_cu);
        (void)hipGetLastError();
        grid = cus;
        if (grid != 256) fprintf(stderr, "kernel_launch: %d CUs (expected 256)\n", grid);
    }
    if (grid < 0) return;
    if (hipMemsetAsync((char*)d_ws + WS_CTL, 0, CTL_ZERO_BYTES, stream) != hipSuccess) return;
    Args a{};
    for (int i = 0; i < N_IN; ++i) a.in[i] = d_in[i];
    a.out = (float*)d_out; a.ws = (unsigned char*)d_ws;
#if MK_ONE_LAUNCH
    a.ph_lo = 0; a.ph_hi = NPH;
    hipLaunchKernelGGL(fwd, dim3(grid), dim3(NTHREADS), LDS_BYTES, stream, a);
#else
    for (int p = 0; p < NPH; ++p) { a.ph_lo = p; a.ph_hi = p + 1; hipLaunchKernelGGL(fwd, dim3(grid), dim3(NTHREADS), LDS_BYTES, stream, a); }
#endif
}
```

```cpp
#include <hip/hip_runtime.h>
#include <cstdio>
#include <cstdint>
namespace pg8 {
#define PG8_LAS __attribute__((address_space(3)))
typedef unsigned short bf16_t;
typedef short bf16x8 __attribute__((ext_vector_type(8)));
typedef float f32x4 __attribute__((ext_vector_type(4)));
typedef unsigned u32x4 __attribute__((ext_vector_type(4)));
constexpr int BM = 256, BK = 64, HALF = 128, HTB = HALF * BK * 2  , STAGE_BYTES = 8 * HTB, NXCD = 8, WGM = 8;

__host__ __device__ __forceinline__ int lds_byte(int r, int c) { const int st = (r >> 4) * 2 + (c >> 5), rr = r & 15, cc = c & 31, ob = rr * 64 + cc * 2; return st * 1024 + (ob ^ (((ob >> 9) & 1) << 5)); }
__host__ __device__ __forceinline__ void stage_rc(int b, int& R, int& C) { const int st = b / 1024, sb = b % 1024, swz = sb ^ (((sb >> 9) & 1) << 5); R = (st >> 1) * 16 + swz / 64; C = (st & 1) * 32 + (swz % 64) / 2; }
__host__ __device__ __forceinline__ int perm32(int rho) { const int n = rho >> 4, i = rho & 15; return 8 * (i >> 2) + 4 * n + (i & 3); }

struct Unit { int pm, pn; };
struct Gemm { const bf16_t* A; const bf16_t* Bt; int M, N, K; };

struct StaticOrder {
    int nM, nN, nwg, G, c;
    __host__ __device__ void init(int M, int N, int G_, int c_) { nM = M / BM; nN = N / BM; nwg = nM * nN; G = G_; c = c_; }
    __host__ __device__ bool next(int i, Unit& u) const {
        const long L = (long)i * G + c; if (L >= nwg) return false;
        int wgid = (int)L; { const int q = nwg / NXCD, r = nwg % NXCD, xcd = wgid % NXCD, off = wgid / NXCD; wgid = (xcd < r ? xcd * (q + 1) : r * (q + 1) + (xcd - r) * q) + off; }
        const int nig = WGM * nN, gid = wgid / nig, fm = gid * WGM, gsz = (nM - fm) < WGM ? (nM - fm) : WGM;
        u.pm = fm + ((wgid % nig) % gsz); u.pn = (wgid % nig) / gsz; return true;
    }
    __device__ __forceinline__ void a_ready(const Unit&) const {}
    __device__ __forceinline__ void done(const Unit&) const {}
};

__device__ __forceinline__ unsigned cvt_pk_bf16(float lo, float hi) { unsigned r; asm volatile("v_cvt_pk_bf16_f32 %0, %1, %2" : "=v"(r) : "v"(lo), "v"(hi)); return r; }
typedef float f32x2 __attribute__((ext_vector_type(2)));
__device__ __forceinline__ f32x2 gelu_pk(f32x2 v) {
    const f32x2 av = __builtin_elementwise_abs(v), d = av * 0.2316418882f + 1.0f;
    f32x2 t; t.x = __builtin_amdgcn_rcpf(d.x); t.y = __builtin_amdgcn_rcpf(d.y);
    f32x2 q = t * 0.5307027145f + (-0.7265760135f); q = q * t + 0.7107068705f; q = q * t + (-0.142248368f); q = q * t + 0.127414796f; q = q * t;
    const f32x2 s = (v * v) * (-0.72134752044f);
    f32x2 e; e.x = __builtin_amdgcn_exp2f(s.x); e.y = __builtin_amdgcn_exp2f(s.y);
    const f32x2 m = v * (q * e), r = v - m;
    f32x2 o; o.x = v.x < 0.f ? m.x : r.x; o.y = v.y < 0.f ? m.y : r.y; return o;
}

template <int ACT  > struct EpiBf16 {
    static constexpr bool PERM = true, AFTER_DRAIN = false; static_assert(ACT == 0 || ACT == 1, "EpiBf16: ACT is 0 (none) or 1 (gelu_pk)");
    bf16_t* O; int ldc; const float* bias; int split_cols; size_t split_stride; float scale0;
    __device__ __forceinline__ void operator()(const f32x4 (&acc)[2][2][4][2], const Unit& u, int wr, int wc, int fr, int fq) const {
        const int row0 = u.pm * BM + wr * 64 + fr; int colt = u.pn * BM; bf16_t* base = O;
        float sc = 1.f; if (split_cols) { const int t = colt / split_cols; base += (size_t)t * split_stride; colt -= t * split_cols; if (t == 0) sc = scale0; }
        const int col0 = colt + wc * 32 + 8 * fq, bcol0 = u.pn * BM + wc * 32 + 8 * fq;
        f32x4 bv[2][2];
#pragma unroll
        for (int bj = 0; bj < 2; ++bj)
#pragma unroll
            for (int n = 0; n < 2; ++n) bv[bj][n] = bias ? *(const f32x4*)(bias + bcol0 + bj * HALF + 4 * n) : (f32x4){0.f, 0.f, 0.f, 0.f};
#pragma unroll
        for (int ai = 0; ai < 2; ++ai)
#pragma unroll
            for (int m = 0; m < 4; ++m) { bf16_t* rowp = base + (size_t)(row0 + ai * HALF + m * 16) * ldc + col0;
#pragma unroll
                for (int bj = 0; bj < 2; ++bj) { f32x4 v0 = acc[ai][bj][m][0] + bv[bj][0], v1 = acc[ai][bj][m][1] + bv[bj][1];
                    if (ACT == 1) { f32x2 a = gelu_pk((f32x2){v0[0], v0[1]}), b = gelu_pk((f32x2){v0[2], v0[3]}), c = gelu_pk((f32x2){v1[0], v1[1]}), d = gelu_pk((f32x2){v1[2], v1[3]});
                        v0 = (f32x4){a.x, a.y, b.x, b.y}; v1 = (f32x4){c.x, c.y, d.x, d.y}; }
                    v0 = v0 * sc; v1 = v1 * sc; u32x4 w; w.x = cvt_pk_bf16(v0[0], v0[1]); w.y = cvt_pk_bf16(v0[2], v0[3]); w.z = cvt_pk_bf16(v1[0], v1[1]); w.w = cvt_pk_bf16(v1[2], v1[3]);
                    *(u32x4*)(rowp + bj * HALF) = w; } }
    }
};
struct EpiF32 {
    static constexpr bool PERM = false, AFTER_DRAIN = false;
    float* C; int ldc; int split_cols; size_t split_stride;
    __device__ __forceinline__ void operator()(const f32x4 (&acc)[2][2][4][2], const Unit& u, int wr, int wc, int fr, int fq) const {
        int colt = u.pn * BM; float* base = C;
        if (split_cols) { const int t = colt / split_cols; base += (size_t)t * split_stride; colt -= t * split_cols; }
        const int row0 = u.pm * BM + wr * 64 + fr, col0 = colt + wc * 32 + 4 * fq;
#pragma unroll
        for (int ai = 0; ai < 2; ++ai)
#pragma unroll
            for (int m = 0; m < 4; ++m) { float* rowp = base + (size_t)(row0 + ai * HALF + m * 16) * ldc + col0;
#pragma unroll
                for (int bj = 0; bj < 2; ++bj)
#pragma unroll
                    for (int n = 0; n < 2; ++n) *(f32x4*)(rowp + bj * HALF + n * 16) = acc[ai][bj][m][n]; }
    }
};
struct EpiF32B {
    static constexpr bool PERM = false, AFTER_DRAIN = false;
    float* C; bf16_t* Cb; int ldc; int split_cols; size_t split_stride, split_stride_b;
    __device__ __forceinline__ void operator()(const f32x4 (&acc)[2][2][4][2], const Unit& u, int wr, int wc, int fr, int fq) const {
        int colt = u.pn * BM; float* base = C; bf16_t* baseb = Cb;
        if (split_cols) { const int t = colt / split_cols; base += (size_t)t * split_stride; baseb += (size_t)t * split_stride_b; colt -= t * split_cols; }
        const int row0 = u.pm * BM + wr * 64 + fr, col0 = colt + wc * 32 + 4 * fq;
        typedef unsigned u32x2v __attribute__((ext_vector_type(2)));
#pragma unroll
        for (int ai = 0; ai < 2; ++ai)
#pragma unroll
            for (int m = 0; m < 4; ++m) { const size_t off = (size_t)(row0 + ai * HALF + m * 16) * ldc + col0;
#pragma unroll
                for (int bj = 0; bj < 2; ++bj)
#pragma unroll
                    for (int n = 0; n < 2; ++n) { const f32x4 v = acc[ai][bj][m][n]; *(f32x4*)(base + off + bj * HALF + n * 16) = v;
                        u32x2v w; w.x = cvt_pk_bf16(v[0], v[1]); w.y = cvt_pk_bf16(v[2], v[3]); *(u32x2v*)(baseb + off + bj * HALF + n * 16) = w; } }
    }
};
template <class Epi, class Sched, bool ALIGN_EPI = false, bool SP2 = false>
__device__ __forceinline__ void gemm_phase(PG8_LAS unsigned char* lds, const Gemm g, const Sched& S, const Epi& E) {
    const int tid = threadIdx.x, wid = __builtin_amdgcn_readfirstlane(tid >> 6), lane = tid & 63, wr = wid >> 2, wc = wid & 3, fr = lane & 15, fq = lane >> 4;
    const int K = g.K, nt = K / BK;
    unsigned voffA[2], voffB[2];
#pragma unroll
    for (int i = 0; i < 2; ++i) { int R, C; stage_rc(tid * 16 + i * 8192, R, C); const int Rb = Epi::PERM ? ((R & ~31) + perm32(R & 31)) : R;
        voffA[i] = (unsigned)(R * K + C) * 2u; voffB[i] = (unsigned)(Rb * K + C) * 2u; }
    const size_t kstep = (size_t)(BK * 2);
    const size_t hstep = (size_t)HALF * K * 2;
    const size_t tstep = 2 * hstep;
    const unsigned ldsw = (unsigned)wid * 1024u;
    const int aoff = lds_byte(wr * 64 + fr, fq * 8), boff = lds_byte(wc * 32 + fr, fq * 8);
#define PG8_SA(b, h) (((b) * 2 + (h)) * HTB)
#define PG8_SB(b, h) ((4 + (b) * 2 + (h)) * HTB)
#define PG8_STAGE(bufoff, gbase, voff) do { _Pragma("unroll") for (int _i = 0; _i < 2; ++_i) \
        __builtin_amdgcn_global_load_lds((const unsigned*)((const char*)(gbase) + (voff)[_i]), (PG8_LAS unsigned*)(lds + (bufoff) + ldsw + _i * 8192), 16, 0, 0); } while (0)
#define PG8_LDA(dst, b, h) do { _Pragma("unroll") for (int m = 0; m < 4; ++m) _Pragma("unroll") for (int k = 0; k < 2; ++k) dst[m][k] = *(const PG8_LAS bf16x8*)(lds + PG8_SA(b, h) + aoff + m * 2048 + k * 1024); } while (0)
#define PG8_LDB(dst, b, h) do { _Pragma("unroll") for (int n = 0; n < 2; ++n) _Pragma("unroll") for (int k = 0; k < 2; ++k) dst[n][k] = *(const PG8_LAS bf16x8*)(lds + PG8_SB(b, h) + boff + n * 2048 + k * 1024); } while (0)
#define PG8_MMA(ai, bj, At, Bt) do { __builtin_amdgcn_s_setprio(1); _Pragma("unroll") for (int m = 0; m < 4; ++m) _Pragma("unroll") for (int n = 0; n < 2; ++n) _Pragma("unroll") for (int k = 0; k < 2; ++k) \
        acc[ai][bj][m][n] = __builtin_amdgcn_mfma_f32_16x16x32_bf16(Bt[n][k], At[m][k], acc[ai][bj][m][n], 0, 0, 0); __builtin_amdgcn_s_setprio(0); } while (0)
#define PG8_WAIT_V(n) asm volatile("s_waitcnt vmcnt(" #n ")" ::: "memory")
#define PG8_WAIT_L(n) asm volatile("s_waitcnt lgkmcnt(" #n ")" ::: "memory")
#define PG8_BAR __builtin_amdgcn_s_barrier()
#define PG8_SCHED __builtin_amdgcn_sched_barrier(0)
    Unit cur, nxt; int ui = 0;
    if (!S.next(0, cur)) return;
    f32x4 acc[2][2][4][2];
#pragma unroll
    for (int a = 0; a < 2; ++a)
#pragma unroll
        for (int b = 0; b < 2; ++b)
#pragma unroll
            for (int m = 0; m < 4; ++m)
#pragma unroll
                for (int n = 0; n < 2; ++n) acc[a][b][m][n] = (f32x4){0.f, 0.f, 0.f, 0.f};
    bf16x8 At[4][2], B0[2][2], B1[2][2];
    const char* cA = (const char*)g.A + (size_t)cur.pm * tstep; const char* cB = (const char*)g.Bt + (size_t)cur.pn * tstep;
    S.a_ready(cur);
    if constexpr (SP2) {
        PG8_STAGE(PG8_SB(0, 0), cB, voffB); PG8_STAGE(PG8_SB(0, 1), cB + hstep, voffB); PG8_STAGE(PG8_SA(0, 0), cA, voffA); PG8_STAGE(PG8_SA(0, 1), cA + hstep, voffA);
        if (wr == 1) PG8_BAR;
        PG8_WAIT_V(2); PG8_BAR;
        PG8_STAGE(PG8_SB(1, 0), cB + kstep, voffB); PG8_STAGE(PG8_SA(1, 0), cA + kstep, voffA); PG8_STAGE(PG8_SB(1, 1), cB + hstep + kstep, voffB);
        PG8_WAIT_V(6); PG8_BAR;
    } else {
        PG8_STAGE(PG8_SB(0, 0), cB, voffB); PG8_STAGE(PG8_SA(0, 0), cA, voffA); PG8_STAGE(PG8_SB(0, 1), cB + hstep, voffB); PG8_STAGE(PG8_SA(0, 1), cA + hstep, voffA);
        if (wr == 1) PG8_BAR;
        PG8_WAIT_V(4); PG8_BAR;
        PG8_STAGE(PG8_SB(1, 0), cB + kstep, voffB); PG8_STAGE(PG8_SA(1, 0), cA + kstep, voffA); PG8_STAGE(PG8_SB(1, 1), cB + hstep + kstep, voffB);
        PG8_WAIT_V(6); PG8_BAR;
    }
    for (;;) {
        const bool has_next = S.next(ui + 1, nxt);
        const char* nA = has_next ? (const char*)g.A + (size_t)nxt.pm * tstep : cA; const char* nB = has_next ? (const char*)g.Bt + (size_t)nxt.pn * tstep : cB;
        for (int t = 0; t < nt; t += 2) {
            const bool last = (t == nt - 2);
            const char* a1 = cA + (size_t)(t + 1) * kstep;
            const char* a2 = last ? nA : cA + (size_t)(t + 2) * kstep; const char* b2 = last ? nB : cB + (size_t)(t + 2) * kstep;
            const char* a3 = a2 + kstep; const char* b3 = b2 + kstep;
            if (last && has_next) S.a_ready(nxt);
            if constexpr (SP2) {
            PG8_LDB(B0, 0, 0); PG8_LDB(B1, 0, 1); PG8_SCHED; PG8_LDA(At, 0, 0); PG8_STAGE(PG8_SA(1, 1), a1 + hstep, voffA);
            PG8_WAIT_V(8); PG8_WAIT_L(0); PG8_BAR; PG8_MMA(0, 0, At, B0); PG8_MMA(0, 1, At, B1); PG8_BAR; PG8_SCHED;
            PG8_LDA(At, 0, 1); PG8_STAGE(PG8_SB(0, 0), b2, voffB); PG8_STAGE(PG8_SB(0, 1), b2 + hstep, voffB); PG8_STAGE(PG8_SA(0, 0), a2, voffA);
            PG8_WAIT_V(8); PG8_WAIT_L(0); PG8_BAR; PG8_MMA(1, 0, At, B0); PG8_MMA(1, 1, At, B1); PG8_BAR; PG8_SCHED;
            PG8_LDB(B0, 1, 0); PG8_LDB(B1, 1, 1); PG8_SCHED; PG8_LDA(At, 1, 0); PG8_STAGE(PG8_SA(0, 1), a2 + hstep, voffA);
            PG8_WAIT_V(8); PG8_WAIT_L(0); PG8_BAR; PG8_MMA(0, 0, At, B0); PG8_MMA(0, 1, At, B1); PG8_BAR; PG8_SCHED;
            PG8_LDA(At, 1, 1); PG8_STAGE(PG8_SB(1, 0), b3, voffB); PG8_STAGE(PG8_SB(1, 1), b3 + hstep, voffB); PG8_STAGE(PG8_SA(1, 0), a3, voffA);
            PG8_WAIT_V(8); PG8_WAIT_L(0); PG8_BAR; PG8_MMA(1, 0, At, B0); PG8_MMA(1, 1, At, B1); PG8_BAR; PG8_SCHED;
            } else {
            PG8_LDB(B0, 0, 0); PG8_SCHED; PG8_LDA(At, 0, 0); PG8_STAGE(PG8_SA(1, 1), a1 + hstep, voffA);
            PG8_WAIT_L(8); PG8_BAR; PG8_WAIT_L(0); PG8_MMA(0, 0, At, B0); PG8_BAR; PG8_SCHED;
            PG8_LDB(B1, 0, 1); PG8_STAGE(PG8_SB(0, 0), b2, voffB);
            PG8_BAR; PG8_WAIT_L(0); PG8_MMA(0, 1, At, B1); PG8_BAR;
            PG8_LDA(At, 0, 1); PG8_STAGE(PG8_SA(0, 0), a2, voffA);
            PG8_BAR; PG8_WAIT_L(0); PG8_MMA(1, 0, At, B0); PG8_BAR; PG8_SCHED;
            PG8_STAGE(PG8_SB(0, 1), b2 + hstep, voffB);
            PG8_WAIT_V(6); PG8_BAR; PG8_MMA(1, 1, At, B1); PG8_BAR;
            PG8_LDB(B0, 1, 0); PG8_SCHED; PG8_LDA(At, 1, 0); PG8_STAGE(PG8_SA(0, 1), a2 + hstep, voffA);
            PG8_WAIT_L(8); PG8_BAR; PG8_WAIT_L(0); PG8_MMA(0, 0, At, B0); PG8_BAR; PG8_SCHED;
            PG8_LDB(B1, 1, 1); PG8_STAGE(PG8_SB(1, 0), b3, voffB);
            PG8_BAR; PG8_WAIT_L(0); PG8_MMA(0, 1, At, B1); PG8_BAR;
            PG8_LDA(At, 1, 1); PG8_STAGE(PG8_SA(1, 0), a3, voffA);
            PG8_BAR; PG8_WAIT_L(0); PG8_MMA(1, 0, At, B0); PG8_BAR; PG8_SCHED;
            PG8_STAGE(PG8_SB(1, 1), b3 + hstep, voffB);
            PG8_WAIT_V(6); PG8_BAR; PG8_MMA(1, 1, At, B1); PG8_BAR;
            }
        }
        if constexpr (ALIGN_EPI) { if (wr == 0) PG8_BAR; }
        if constexpr (!Epi::AFTER_DRAIN) { E(acc, cur, wr, wc, fr, fq); S.done(cur); }
        if (!has_next) break;
#pragma unroll
        for (int a = 0; a < 2; ++a)
#pragma unroll
            for (int b = 0; b < 2; ++b)
#pragma unroll
                for (int m = 0; m < 4; ++m)
#pragma unroll
                    for (int n = 0; n < 2; ++n) acc[a][b][m][n] = (f32x4){0.f, 0.f, 0.f, 0.f};
        cur = nxt; cA = nA; cB = nB; ++ui;
        if constexpr (ALIGN_EPI) { if (wr == 1) PG8_BAR; }
    }
    PG8_WAIT_V(0);
    if constexpr (!ALIGN_EPI) { if (wr == 0) PG8_BAR; }
    PG8_BAR;
    if constexpr (Epi::AFTER_DRAIN) { E.fused(acc, cur, wr, wc, fr, fq, lds, wid, lane); S.done(cur); }
#undef PG8_SA
#undef PG8_SB
#undef PG8_STAGE
#undef PG8_LDA
#undef PG8_LDB
#undef PG8_MMA
#undef PG8_WAIT_V
#undef PG8_WAIT_L
#undef PG8_BAR
#undef PG8_SCHED
}
}
#define GAS __attribute__((address_space(1)))
#define LAS __attribute__((address_space(3)))
typedef unsigned short bf16;
typedef unsigned v4u __attribute__((ext_vector_type(4)));
typedef float f32x4 __attribute__((ext_vector_type(4)));
typedef short bf16x8 __attribute__((ext_vector_type(8)));
typedef GAS unsigned gu32;
typedef GAS unsigned long long gu64;
#define RLX_AGENT __ATOMIC_RELAXED, __HIP_MEMORY_SCOPE_AGENT
#define LDS_WAIT() asm volatile("s_waitcnt lgkmcnt(0)" ::: "memory")
#define VM_WAIT() asm volatile("s_waitcnt vmcnt(0)" ::: "memory")
__device__ __forceinline__ unsigned long long rt() { return __builtin_amdgcn_s_memrealtime(); }
__device__ __forceinline__ unsigned f2bf(float f) { unsigned u = __builtin_bit_cast(unsigned, f); return (u + 0x7fffu + ((u >> 16) & 1u)) >> 16; }
__device__ __forceinline__ unsigned pk2(float lo, float hi) { return f2bf(lo) | (f2bf(hi) << 16); }

#define XB_TMO      128
#define XB_XCNT(j)  (256  + 64 * (j))
#define XB_XSUB(j)  (1280 + 64 * (j))
#define XB_XGEN(j)  (2304 + 64 * (j))
#define XB_TOP      3328
#define XB_TOPGEN   3392
#define XCD_BAR_WORDS 3456
#define XB_SPIN_CAP (1u << 18)

__device__ __forceinline__ unsigned xb_ld(unsigned* p)              { return __hip_atomic_load(p, __ATOMIC_RELAXED, __HIP_MEMORY_SCOPE_AGENT); }
__device__ __forceinline__ unsigned xb_add(unsigned* p, unsigned v) { return __hip_atomic_fetch_add(p, v, __ATOMIC_RELAXED, __HIP_MEMORY_SCOPE_AGENT); }
__device__ __forceinline__ unsigned xb_xcc_id() { return (unsigned)__builtin_amdgcn_s_getreg((3 << 11) | 20) & 0xFu; }
#define XB_SPIN(cond, bar) do { unsigned _sp = 0; while (cond) { __builtin_amdgcn_s_sleep(1); \
    if ((++_sp & 255u) == 0u) { if (xb_ld(&(bar)[XB_TMO])) break; if (_sp > XB_SPIN_CAP) { atomicAdd(&(bar)[XB_TMO], 1u); break; } } } } while (0)

struct XcdBarrier {
    unsigned* bar; unsigned x;
    volatile LAS unsigned* st;
};

__device__ __forceinline__ XcdBarrier xcd_barrier_post(unsigned* bar, volatile LAS unsigned* st) {
    XcdBarrier b; b.bar = bar; b.x = xb_xcc_id(); b.st = st;
    if (threadIdx.x == 0) (void)xb_add(&bar[XB_XCNT(b.x)], 1u);
    return b;
}
__device__ __forceinline__ void xcd_barrier_complete(unsigned* bar, unsigned x, unsigned& nloc, unsigned& nx) {
    const unsigned G = gridDim.x * gridDim.y * gridDim.z;
    unsigned sum, cnt, mine, sp = 0u;
    for (;;) {
        sum = 0u; cnt = 0u; mine = 0u;
#pragma unroll
        for (unsigned j = 0; j < 16; ++j) { const unsigned c = xb_ld(&bar[XB_XCNT(j)]); sum += c; cnt += (c > 0u) ? 1u : 0u; mine = (j == x) ? c : mine; }
        if (sum == G) break;
        __builtin_amdgcn_s_sleep(1);
        if ((++sp & 255u) == 0u) { if (xb_ld(&bar[XB_TMO])) break; if (sp > XB_SPIN_CAP) { atomicAdd(&bar[XB_TMO], 1u); break; } }
    }
    nloc = mine > 0u ? mine : 1u; nx = cnt > 0u ? cnt : 1u;
}

__device__ __forceinline__ void xcd_barrier(const XcdBarrier& b) {
    asm volatile("s_waitcnt vmcnt(0)" ::: "memory");
    __syncthreads();
    if (threadIdx.x == 0) {
        unsigned* bar = b.bar;
        __builtin_amdgcn_s_waitcnt(0);
        unsigned nloc = b.st[0], nx = b.st[1];
        if (nloc == 0u) { xcd_barrier_complete(bar, b.x, nloc, nx); b.st[0] = nloc; b.st[1] = nx; }
        const unsigned old = xb_add(&bar[XB_XSUB(b.x)], 1u);
        const unsigned gen = old / nloc;
        if (old + 1u == (gen + 1u) * nloc) {
            __builtin_amdgcn_fence(__ATOMIC_RELEASE, "agent");
            asm volatile("s_waitcnt vmcnt(0)" ::: "memory");
            const unsigned og = xb_add(&bar[XB_TOP], 1u);
            const unsigned tg = og / nx;
            if (og + 1u == (tg + 1u) * nx) xb_add(&bar[XB_TOPGEN], 1u);
            else XB_SPIN(xb_ld(&bar[XB_TOPGEN]) == tg, bar);
            __builtin_amdgcn_fence(__ATOMIC_ACQUIRE, "agent");
            xb_add(&bar[XB_XGEN(b.x)], 1u);
            asm volatile("s_waitcnt vmcnt(0)" ::: "memory");
        } else {
            XB_SPIN(xb_ld(&bar[XB_XGEN(b.x)]) == gen, bar);
            __builtin_amdgcn_fence(__ATOMIC_ACQUIRE, "agent");
            asm volatile("s_waitcnt vmcnt(0)" ::: "memory");
        }
    }
    __syncthreads();
}

namespace sbp {
using bf16x8 = __attribute__((ext_vector_type(8))) short;
using s16x4 = __attribute__((ext_vector_type(4))) short;
using f32x16 = __attribute__((ext_vector_type(16))) float;
using u32x4 = __attribute__((ext_vector_type(4))) unsigned;
typedef short v4i16_t __attribute__((ext_vector_type(4)));
typedef __attribute__((address_space(3))) const char* lds_cptr;
constexpr int PITCH = 512, OPITCH = 1024;
constexpr int NSLOT = 3, SLOTB = 8192;
constexpr int LDS_K = 0, LDS_V = NSLOT * SLOTB, LDS_OST = 2 * NSLOT * SLOTB, LDS_BYTES = LDS_OST + 8 * 4096;
__device__ __forceinline__ int crow(int r, int hi) { return (r & 3) + 8 * (r >> 2) + 4 * hi; }
__device__ __forceinline__ void glds16(const void* gsrc, unsigned lds_dst) { unsigned keep;
    asm volatile("s_mov_b32 %0, m0\n\ts_mov_b32 m0, %2\n\ts_nop 0\n\tglobal_load_lds_dwordx4 %1, off\n\ts_mov_b32 m0, %0" : "=&s"(keep) : "v"(gsrc), "s"(lds_dst) : "memory"); }
typedef float f32x2_t __attribute__((ext_vector_type(2))); typedef __bf16 bf16x2_t __attribute__((ext_vector_type(2)));
__device__ __forceinline__ unsigned cvtpk(float lo, float hi) { f32x2_t v = {lo, hi}; bf16x2_t b = __builtin_convertvector(v, bf16x2_t); return __builtin_bit_cast(unsigned, b); }
#define SBP_WAIT_BAR(N) asm volatile("s_waitcnt vmcnt(" #N ") lgkmcnt(0)\n\ts_barrier" ::: "memory")

__device__ __forceinline__ void qkt(f32x16& p0, f32x16& p1, lds_cptr Kslot, const bf16x8* qr, const f32x16& cinit, int r32, int hi) {
    lds_cptr kb = Kslot + hi * 1024 + r32 * 16;
#pragma unroll
    for (int d0 = 0; d0 < 4; ++d0) {
        const bf16x8 b0 = *(const __attribute__((address_space(3))) bf16x8*)(kb + d0 * 2048);
        const bf16x8 b1 = *(const __attribute__((address_space(3))) bf16x8*)(kb + d0 * 2048 + 512);
        if (d0 == 0) { p0 = __builtin_amdgcn_mfma_f32_32x32x16_bf16(b0, qr[0], cinit, 0, 0, 0); p1 = __builtin_amdgcn_mfma_f32_32x32x16_bf16(b1, qr[0], cinit, 0, 0, 0); }
        else { p0 = __builtin_amdgcn_mfma_f32_32x32x16_bf16(b0, qr[d0], p0, 0, 0, 0); p1 = __builtin_amdgcn_mfma_f32_32x32x16_bf16(b1, qr[d0], p1, 0, 0, 0); } }
}
__device__ __forceinline__ void pv(f32x16* o, int vb, bf16x8 pa0, bf16x8 pa1, bf16x8 pa2, bf16x8 pa3) {
#pragma unroll
    for (int d0 = 0; d0 < 2; ++d0) { s16x4 lo[4], hi[4];
#pragma unroll
        for (int ks = 0; ks < 4; ++ks) {
            asm volatile("ds_read_b64_tr_b16 %0,%1 offset:%c2" : "=&v"(lo[ks]) : "v"(vb), "i"(d0 * 4096 + ks * 1024) : "memory");
            asm volatile("ds_read_b64_tr_b16 %0,%1 offset:%c2" : "=&v"(hi[ks]) : "v"(vb), "i"(d0 * 4096 + ks * 1024 + 512) : "memory"); }
        asm volatile("s_waitcnt lgkmcnt(0)" ::: "memory"); __builtin_amdgcn_sched_barrier(0);
#define SBP_PK(k) (bf16x8){lo[k][0], lo[k][1], lo[k][2], lo[k][3], hi[k][0], hi[k][1], hi[k][2], hi[k][3]}
        o[d0] = __builtin_amdgcn_mfma_f32_32x32x16_bf16(pa0, SBP_PK(0), o[d0], 0, 0, 0);
        o[d0] = __builtin_amdgcn_mfma_f32_32x32x16_bf16(pa1, SBP_PK(1), o[d0], 0, 0, 0);
        o[d0] = __builtin_amdgcn_mfma_f32_32x32x16_bf16(pa2, SBP_PK(2), o[d0], 0, 0, 0);
        o[d0] = __builtin_amdgcn_mfma_f32_32x32x16_bf16(pa3, SBP_PK(3), o[d0], 0, 0, 0);
#undef SBP_PK
    }
}
template <bool MASKED>
__device__ __forceinline__ void sb_tile(const f32x16& p0, const f32x16& p1, float& carry, float f0, int hi, int kbase, int qrel, u32x4& pw0, u32x4& pw1, u32x4& pw2, u32x4& pw3) {
    float z[32], l[32], a[32];
#pragma unroll
    for (int r = 0; r < 16; ++r) { z[r] = p0[r]; z[16 + r] = p1[r]; }
#pragma unroll
    for (int e = 0; e < 32; ++e) {
        const float ex = __builtin_amdgcn_exp2f(fminf(z[e], 60.f));
        l[e] = -__builtin_amdgcn_logf(1.0f + ex);
        if (MASKED) { const int key = kbase + 8 * (e >> 2) + 4 * hi + (e & 3); if (key >= qrel) l[e] = 0.f; }
    }
    float G[8], PS[8];
#pragma unroll
    for (int k = 0; k < 8; ++k) { G[k] = (l[4 * k] + l[4 * k + 1]) + (l[4 * k + 2] + l[4 * k + 3]);
        const auto rr = __builtin_amdgcn_permlane32_swap(__float_as_uint(G[k]), __float_as_uint(G[k]), false, false);
        PS[k] = __uint_as_float(rr[0]) + __uint_as_float(rr[1]); }
    float suf = carry;
#pragma unroll
    for (int k = 7; k >= 0; --k) {
        float run = suf + f0 * (PS[k] - G[k]);
#pragma unroll
        for (int j = 3; j >= 0; --j) { const int e = 4 * k + j;
            float v = __builtin_amdgcn_exp2f((z[e] + l[e]) + run);
            if (MASKED) { const int key = kbase + 8 * k + 4 * hi + j; if (key >= qrel) v = 0.f; }
            a[e] = v; run += l[e]; }
        suf += PS[k];
    }
    carry = suf;
    pw0 = (u32x4){cvtpk(a[0], a[1]), cvtpk(a[2], a[3]), cvtpk(a[4], a[5]), cvtpk(a[6], a[7])};
    pw1 = (u32x4){cvtpk(a[8], a[9]), cvtpk(a[10], a[11]), cvtpk(a[12], a[13]), cvtpk(a[14], a[15])};
    pw2 = (u32x4){cvtpk(a[16], a[17]), cvtpk(a[18], a[19]), cvtpk(a[20], a[21]), cvtpk(a[22], a[23])};
    pw3 = (u32x4){cvtpk(a[24], a[25]), cvtpk(a[26], a[27]), cvtpk(a[28], a[29]), cvtpk(a[30], a[31])};
}

__device__ __forceinline__ void unit(int b, int h, int qb, const unsigned short* Q, const unsigned short* K, const unsigned short* V, unsigned short* O, float bias2, __attribute__((address_space(3))) unsigned char* shm3u) {
    const int tid = threadIdx.x, lane = tid & 63, r32 = lane & 31, hi = lane >> 5; const int wid = __builtin_amdgcn_readfirstlane(tid >> 6);
    const long rowbase = (long)b * 2048; const int q0 = qb * 256;
    const unsigned short* Qw = Q + (rowbase + q0 + wid * 32) * PITCH + h * 64;
    const unsigned short* Kh = K + rowbase * PITCH + h * 64; const unsigned short* Vh = V + rowbase * PITCH + h * 64;
    const lds_cptr shm3 = (lds_cptr)shm3u;
    const unsigned lds0 = (unsigned)(uintptr_t)shm3u;
    const unsigned short* ksrc = Kh + (long)lane * PITCH + wid * 8;
    const unsigned short* vsrc = Vh + (long)(16 * (wid & 3) + (lane >> 2)) * PITCH + (wid >> 2) * 32 + (lane & 3) * 8;
    const unsigned kdst = lds0 + LDS_K + wid * 1024, vdst = lds0 + LDS_V + wid * 1024;
#define SBP_DMA_K(t, slot) glds16(ksrc + (long)(t) * 64 * PITCH, (unsigned)__builtin_amdgcn_readfirstlane(kdst + (slot)))
#define SBP_DMA_V(t, slot) glds16(vsrc + (long)(t) * 64 * PITCH, (unsigned)__builtin_amdgcn_readfirstlane(vdst + (slot)))
    const int vb0 = (int)(lds0 + LDS_V) + ((lane >> 4) & 1) * 32 + (lane & 3) * 8 + (4 * hi + ((lane & 15) >> 2)) * 64;
    const int NT = 4 * qb + 4;
    bf16x8 qr[4];
#pragma unroll
    for (int d0 = 0; d0 < 4; ++d0) qr[d0] = *reinterpret_cast<const bf16x8*>(&Qw[(long)r32 * PITCH + d0 * 16 + hi * 8]);
    SBP_DMA_K(NT - 1, 0); SBP_DMA_V(NT - 1, 0);
    SBP_DMA_K(NT - 2, SLOTB); SBP_DMA_V(NT - 2, SLOTB);
    f32x16 o[2]; o[0] = f32x16{}; o[1] = f32x16{};
    f32x16 cinit;
#pragma unroll
    for (int r = 0; r < 16; ++r) cinit[r] = bias2;
    const float f0 = hi == 0 ? 1.f : 0.f;
    const int qrel = wid * 32 + r32;
    float carry = 0.f;
    int sl_cur = 0, sl_nn = 2 * SLOTB;
    for (int i = 0; i < NT; ++i) {
        if (i + 1 < NT) { SBP_WAIT_BAR(2); } else { SBP_WAIT_BAR(0); }
        if (i + 2 < NT) { SBP_DMA_K(NT - 3 - i, sl_nn); SBP_DMA_V(NT - 3 - i, sl_nn); }
        const int jb = 3 - i;
        const bool skip = (i < 4) && (64 * jb >= wid * 32 + 31);
        if (!skip) {
            f32x16 p0, p1; u32x4 pw0, pw1, pw2, pw3;
            qkt(p0, p1, shm3 + LDS_K + sl_cur, qr, cinit, r32, hi);
            if (i < 4) sb_tile<true>(p0, p1, carry, f0, hi, 64 * jb, qrel, pw0, pw1, pw2, pw3);
            else sb_tile<false>(p0, p1, carry, f0, hi, 0, 0, pw0, pw1, pw2, pw3);
            pv(o, vb0 + sl_cur, __builtin_bit_cast(bf16x8, pw0), __builtin_bit_cast(bf16x8, pw1), __builtin_bit_cast(bf16x8, pw2), __builtin_bit_cast(bf16x8, pw3));
        }
        sl_cur = (sl_cur == 2 * SLOTB) ? 0 : sl_cur + SLOTB; sl_nn = (sl_nn == 2 * SLOTB) ? 0 : sl_nn + SLOTB;
    }
    unsigned short* Ow = O + (rowbase + q0 + wid * 32) * OPITCH + h * 64;
    { __attribute__((address_space(3))) unsigned short* stg = (__attribute__((address_space(3))) unsigned short*)(shm3u + LDS_OST) + wid * 2048;
#pragma unroll
        for (int r = 0; r < 16; ++r) { const int orow = crow(r, hi);
#pragma unroll
            for (int d0 = 0; d0 < 2; ++d0) stg[orow * 64 + d0 * 32 + r32] = (unsigned short)f2bf(o[d0][r]); }
        asm volatile("s_waitcnt lgkmcnt(0)" ::: "memory");
#pragma unroll
        for (int i = 0; i < 4; ++i) { const int row = i * 8 + (lane >> 3), ch = lane & 7; const u32x4 v = *(const __attribute__((address_space(3))) u32x4*)(stg + row * 64 + ch * 8); *(u32x4*)(Ow + (long)row * OPITCH + ch * 8) = v; } }
    asm volatile("s_waitcnt lgkmcnt(0)\n\ts_barrier" ::: "memory");
#undef SBP_DMA_K
#undef SBP_DMA_V
}
#undef SBP_WAIT_BAR
}

namespace retp {
using bf16x8 = __attribute__((ext_vector_type(8))) short;
using f32x16 = __attribute__((ext_vector_type(16))) float;
using u32x4 = __attribute__((ext_vector_type(4))) unsigned;
using u32x2 = __attribute__((ext_vector_type(2))) unsigned;
#define RLAS __attribute__((address_space(3)))
constexpr int CH = 64, NCH = 2048 / CH;
constexpr int PQ = 272, PT = 144;
constexpr int L_QS = 0, L_KS = L_QS + 64 * PQ, L_VT = L_KS + 64 * PQ, L_KDT = L_VT + 128 * PT, L_PS = L_KDT + 128 * PT, L_ST = L_PS + 64 * PT, L_END = L_ST + 128 * PQ;
static_assert(L_END <= 131072, "retention LDS");
__device__ __forceinline__ int crow(int r, int hi) { return (r & 3) + 8 * (r >> 2) + 4 * hi; }
__device__ __forceinline__ bf16x8 frag(RLAS const unsigned char* base, int row, int pitch, int kbyte, int hi) { return *(RLAS const bf16x8*)(base + row * pitch + kbyte + 16 * hi); }

__device__ __forceinline__ void unit(int b, int h, const unsigned short* QR, const unsigned short* KR, const unsigned short* VR, float* OR, float* Sout, RLAS unsigned char* lds) {
    const int tid = threadIdx.x, lane = tid & 63, r32 = lane & 31, hi = lane >> 5; const int w = __builtin_amdgcn_readfirstlane(tid >> 6);
    const float lg2 = log2f(1.0f - exp2f(-5.0f - (float)h));
    const long rowbase = (long)b * 2048;
    for (int i = tid; i < (L_END - L_PS) / 16; i += 512) *(RLAS u32x4*)(lds + L_PS + 16 * i) = (u32x4){0u, 0u, 0u, 0u};
    f32x16 S0 = f32x16{}, S1 = f32x16{};
    const int eb = w >> 1, db0 = 2 * (w & 1);
    const unsigned short* gq = QR + (rowbase + lane) * 512 + h * 128 + 16 * w;
    const unsigned short* gk = KR + (rowbase + lane) * 512 + h * 128 + 16 * w;
    const unsigned short* gv = VR + (rowbase + lane) * 512 + h * 128 + 16 * w;
    u32x4 q0 = *(const u32x4*)gq, q1 = *(const u32x4*)(gq + 8), k0 = *(const u32x4*)gk, k1 = *(const u32x4*)(gk + 8), v0 = *(const u32x4*)gv, v1 = *(const u32x4*)(gv + 8);
    const float kdec = exp2f(lg2 * (float)(63 - lane));
    const float g64 = exp2f(lg2 * 64.0f);
    __syncthreads();
    for (int c = 0; c < NCH; ++c) {
        *(RLAS u32x4*)(lds + L_QS + lane * PQ + 32 * w) = q0; *(RLAS u32x4*)(lds + L_QS + lane * PQ + 32 * w + 16) = q1;
        *(RLAS u32x4*)(lds + L_KS + lane * PQ + 32 * w) = k0; *(RLAS u32x4*)(lds + L_KS + lane * PQ + 32 * w + 16) = k1;
#pragma unroll
        for (int q = 0; q < 8; ++q) {
            const unsigned kv = q < 4 ? k0[q] : k1[q - 4], vv = q < 4 ? v0[q] : v1[q - 4];
            const float ka = __uint_as_float(kv << 16) * kdec, kb = __uint_as_float(kv & 0xffff0000u) * kdec;
            *(RLAS unsigned short*)(lds + L_KDT + (16 * w + 2 * q) * PT + 2 * lane) = (unsigned short)f2bf(ka);
            *(RLAS unsigned short*)(lds + L_KDT + (16 * w + 2 * q + 1) * PT + 2 * lane) = (unsigned short)f2bf(kb);
            *(RLAS unsigned short*)(lds + L_VT + (16 * w + 2 * q) * PT + 2 * lane) = (unsigned short)(vv & 0xffffu);
            *(RLAS unsigned short*)(lds + L_VT + (16 * w + 2 * q + 1) * PT + 2 * lane) = (unsigned short)(vv >> 16);
        }
        if (c > 0) {
#pragma unroll
            for (int r = 0; r < 16; ++r) { const int e = 32 * eb + crow(r, hi);
                *(RLAS unsigned short*)(lds + L_ST + e * PQ + (32 * db0 + r32) * 2) = (unsigned short)f2bf(S0[r]);
                *(RLAS unsigned short*)(lds + L_ST + e * PQ + (32 * (db0 + 1) + r32) * 2) = (unsigned short)f2bf(S1[r]); }
        }
        __syncthreads();
        if (c + 1 < NCH) { const long o = (long)(c + 1) * CH * 512;
            q0 = *(const u32x4*)(gq + o); q1 = *(const u32x4*)(gq + o + 8); k0 = *(const u32x4*)(gk + o); k1 = *(const u32x4*)(gk + o + 8); v0 = *(const u32x4*)(gv + o); v1 = *(const u32x4*)(gv + o + 8); }
        if (w < 3) {
            const int jb = w >> 1, ib = (w + 1) >> 1;
            f32x16 s = f32x16{};
#pragma unroll
            for (int ks = 0; ks < 8; ++ks) s = __builtin_amdgcn_mfma_f32_32x32x16_bf16(frag(lds + L_KS, 32 * jb + r32, PQ, 32 * ks, hi), frag(lds + L_QS, 32 * ib + r32, PQ, 32 * ks, hi), s, 0, 0, 0);
            const int i = 32 * ib + r32;
#pragma unroll
            for (int g = 0; g < 4; ++g) { float pvv[4];
#pragma unroll
                for (int jj = 0; jj < 4; ++jj) { const int j = 32 * jb + 8 * g + 4 * hi + jj; pvv[jj] = (i >= j) ? s[4 * g + jj] * exp2f(lg2 * (float)(i - j)) : 0.f; }
                *(RLAS u32x2*)(lds + L_PS + i * PT + (32 * jb + 8 * g + 4 * hi) * 2) = (u32x2){pk2(pvv[0], pvv[1]), pk2(pvv[2], pvv[3])}; }
        }
        __syncthreads();
        { const int ib = w >> 2, eo = w & 3;
            f32x16 oi = f32x16{}, oc = f32x16{};
#pragma unroll
            for (int ks = 0; ks < 4; ++ks) oi = __builtin_amdgcn_mfma_f32_32x32x16_bf16(frag(lds + L_PS, 32 * ib + r32, PT, 32 * ks, hi), frag(lds + L_VT, 32 * eo + r32, PT, 32 * ks, hi), oi, 0, 0, 0);
#pragma unroll
            for (int ks = 0; ks < 8; ++ks) oc = __builtin_amdgcn_mfma_f32_32x32x16_bf16(frag(lds + L_QS, 32 * ib + r32, PQ, 32 * ks, hi), frag(lds + L_ST, 32 * eo + r32, PQ, 32 * ks, hi), oc, 0, 0, 0);
            float* op = OR + (rowbase + (long)c * CH) * 512 + h * 128 + 32 * eo + r32;
#pragma unroll
            for (int r = 0; r < 16; ++r) { const int i = 32 * ib + crow(r, hi); op[(long)i * 512] = oi[r] + exp2f(lg2 * (float)(i + 1)) * oc[r]; }
        }
#pragma unroll
        for (int r = 0; r < 16; ++r) { S0[r] *= g64; S1[r] *= g64; }
#pragma unroll
        for (int ks = 0; ks < 4; ++ks) { const bf16x8 a = frag(lds + L_VT, 32 * eb + r32, PT, 32 * ks, hi);
            S0 = __builtin_amdgcn_mfma_f32_32x32x16_bf16(a, frag(lds + L_KDT, 32 * db0 + r32, PT, 32 * ks, hi), S0, 0, 0, 0);
            S1 = __builtin_amdgcn_mfma_f32_32x32x16_bf16(a, frag(lds + L_KDT, 32 * (db0 + 1) + r32, PT, 32 * ks, hi), S1, 0, 0, 0); }
        __syncthreads();
    }
#pragma unroll
    for (int r = 0; r < 16; ++r) { const int e = 32 * eb + crow(r, hi);
        Sout[(long)(32 * db0 + r32) * 128 + e] = S0[r]; Sout[(long)(32 * (db0 + 1) + r32) * 128 + e] = S1[r]; }
}
#undef RLAS
}

namespace crs {
using bf16x8 = __attribute__((ext_vector_type(8))) short;
using s16x4 = __attribute__((ext_vector_type(4))) short;
using f32x16 = __attribute__((ext_vector_type(16))) float;
using u32x4 = __attribute__((ext_vector_type(4))) unsigned;
typedef __attribute__((address_space(3))) const char* lds_cptr;
constexpr int PITCH = 1024, SLOT = 32768, L_KA = 0, L_KB = SLOT, L_VA = 2 * SLOT, L_VB = 3 * SLOT;
__device__ __forceinline__ int crow(int r, int hi) { return (r & 3) + 8 * (r >> 2) + 4 * hi; }
#define CRS_WAIT_BAR(N) asm volatile("s_waitcnt vmcnt(" #N ") lgkmcnt(0)\n\ts_barrier" ::: "memory")

__device__ __forceinline__ void scores(f32x16& pa, f32x16& pb, lds_cptr slot, const bf16x8* qr, int r32, int hi) {
    lds_cptr kb = slot + hi * 1024 + r32 * 16;
    pa = f32x16{}; pb = f32x16{};
#pragma unroll
    for (int ks = 0; ks < 16; ++ks) {
        const bf16x8 b0 = *(const __attribute__((address_space(3))) bf16x8*)(kb + ks * 2048);
        const bf16x8 b1 = *(const __attribute__((address_space(3))) bf16x8*)(kb + ks * 2048 + 512);
        pa = __builtin_amdgcn_mfma_f32_32x32x16_bf16(b0, qr[ks], pa, 0, 0, 0);
        pb = __builtin_amdgcn_mfma_f32_32x32x16_bf16(b1, qr[ks], pb, 0, 0, 0); }
}
template <int DH>
__device__ __forceinline__ void pv4(f32x16* o, int vb, bf16x8 pa0, bf16x8 pa1, bf16x8 pa2, bf16x8 pa3) {
#pragma unroll
    for (int d0 = 0; d0 < 4; ++d0) { s16x4 lo[4], hi[4];
#pragma unroll
        for (int ks = 0; ks < 4; ++ks) {
            asm volatile("ds_read_b64_tr_b16 %0,%1 offset:%c2" : "=&v"(lo[ks]) : "v"(vb), "i"((DH * 4 + d0) * 4096 + ks * 1024) : "memory");
            asm volatile("ds_read_b64_tr_b16 %0,%1 offset:%c2" : "=&v"(hi[ks]) : "v"(vb), "i"((DH * 4 + d0) * 4096 + ks * 1024 + 512) : "memory"); }
        asm volatile("s_waitcnt lgkmcnt(0)" ::: "memory"); __builtin_amdgcn_sched_barrier(0);
#define CRS_PK(k) (bf16x8){lo[k][0], lo[k][1], lo[k][2], lo[k][3], hi[k][0], hi[k][1], hi[k][2], hi[k][3]}
        o[d0] = __builtin_amdgcn_mfma_f32_32x32x16_bf16(pa0, CRS_PK(0), o[d0], 0, 0, 0);
        o[d0] = __builtin_amdgcn_mfma_f32_32x32x16_bf16(pa1, CRS_PK(1), o[d0], 0, 0, 0);
        o[d0] = __builtin_amdgcn_mfma_f32_32x32x16_bf16(pa2, CRS_PK(2), o[d0], 0, 0, 0);
        o[d0] = __builtin_amdgcn_mfma_f32_32x32x16_bf16(pa3, CRS_PK(3), o[d0], 0, 0, 0);
#undef CRS_PK
    }
}
__device__ __forceinline__ float hmax16(const f32x16& v) { float a = fmaxf(fmaxf(v[0], v[1]), fmaxf(v[2], v[3])), b = fmaxf(fmaxf(v[4], v[5]), fmaxf(v[6], v[7])), c = fmaxf(fmaxf(v[8], v[9]), fmaxf(v[10], v[11])), d = fmaxf(fmaxf(v[12], v[13]), fmaxf(v[14], v[15])); return fmaxf(fmaxf(a, b), fmaxf(c, d)); }
__device__ __forceinline__ float expsum16(f32x16& v, float m) { float s = 0.f;
#pragma unroll
    for (int r = 0; r < 16; ++r) { v[r] = __builtin_amdgcn_exp2f(v[r] - m); s += v[r]; } return s; }
__device__ __forceinline__ unsigned cvtpk(float lo, float hi) { typedef float f2 __attribute__((ext_vector_type(2))); typedef __bf16 b2 __attribute__((ext_vector_type(2))); f2 v = {lo, hi}; b2 b = __builtin_convertvector(v, b2); return __builtin_bit_cast(unsigned, b); }
__device__ __forceinline__ void pack16(const f32x16& v, float s, u32x4& lo, u32x4& hi) {
    lo = (u32x4){cvtpk(v[0] * s, v[1] * s), cvtpk(v[2] * s, v[3] * s), cvtpk(v[4] * s, v[5] * s), cvtpk(v[6] * s, v[7] * s)};
    hi = (u32x4){cvtpk(v[8] * s, v[9] * s), cvtpk(v[10] * s, v[11] * s), cvtpk(v[12] * s, v[13] * s), cvtpk(v[14] * s, v[15] * s)}; }

__device__ __forceinline__ void unit(const unsigned short* Qt, const unsigned short* Kh, const unsigned short* Vh, unsigned short* Ot, __attribute__((address_space(3))) unsigned char* shm3u) {
    const int tid = threadIdx.x, lane = tid & 63, r32 = lane & 31, hi = lane >> 5; const int wid = __builtin_amdgcn_readfirstlane(tid >> 6);
    const lds_cptr shm3 = (lds_cptr)shm3u; const unsigned lds0 = (unsigned)(uintptr_t)shm3u;
    const unsigned kvoff = (unsigned)(lane * PITCH * 2 + wid * 16);
    const unsigned vvoff = (unsigned)((16 * (wid & 3) + (lane >> 2)) * PITCH * 2 + (wid >> 2) * 64 + (lane & 3) * 16);
#define CRS_GLDS(sbase, voff, imm, ldsdst) do { unsigned keep_; asm volatile("s_mov_b32 %0, m0\n\ts_mov_b32 m0, %3\n\ts_nop 0\n\tglobal_load_lds_dwordx4 %1, %2 offset:%c4\n\ts_mov_b32 m0, %0" : "=&s"(keep_) : "v"(voff), "s"(sbase), "s"(ldsdst), "i"(imm) : "memory"); } while (0)
#define CRS_DMA_K(t, slot) do { const unsigned short* sb_ = Kh + (long)(t) * 64 * PITCH; _Pragma("unroll") for (int i_ = 0; i_ < 4; ++i_) CRS_GLDS(sb_, kvoff, i_ * 128, (unsigned)__builtin_amdgcn_readfirstlane(lds0 + (slot) + (wid + 8 * i_) * 1024 - i_ * 128)); } while (0)
#define CRS_DMA_V(t, slot) do { const unsigned short* sb_ = Vh + (long)(t) * 64 * PITCH; _Pragma("unroll") for (int i_ = 0; i_ < 4; ++i_) CRS_GLDS(sb_, vvoff, i_ * 128, (unsigned)__builtin_amdgcn_readfirstlane(lds0 + (slot) + (wid + 8 * i_) * 1024 - i_ * 128)); } while (0)
    bf16x8 qr[16];
    const unsigned short* Qw = Qt + (long)(wid * 32 + r32) * PITCH + hi * 8;
#pragma unroll
    for (int ks = 0; ks < 16; ++ks) qr[ks] = *reinterpret_cast<const bf16x8*>(Qw + ks * 16);
    CRS_DMA_K(0, L_KA); CRS_DMA_K(1, L_KB); CRS_DMA_V(0, L_VA); CRS_DMA_V(1, L_VB);
    f32x16 p0, p1, p2, p3, p4, p5, p6, p7;
    CRS_WAIT_BAR(12); scores(p0, p1, shm3 + L_KA, qr, r32, hi);
    CRS_WAIT_BAR(8); CRS_DMA_K(2, L_KA); scores(p2, p3, shm3 + L_KB, qr, r32, hi);
    CRS_WAIT_BAR(0); CRS_DMA_K(3, L_KB); scores(p4, p5, shm3 + L_KA, qr, r32, hi);
    CRS_WAIT_BAR(0); CRS_DMA_V(2, L_KA); scores(p6, p7, shm3 + L_KB, qr, r32, hi);
    float m = fmaxf(fmaxf(fmaxf(hmax16(p0), hmax16(p1)), fmaxf(hmax16(p2), hmax16(p3))), fmaxf(fmaxf(hmax16(p4), hmax16(p5)), fmaxf(hmax16(p6), hmax16(p7))));
    { const auto rr = __builtin_amdgcn_permlane32_swap(__float_as_uint(m), __float_as_uint(m), false, false); m = fmaxf(__uint_as_float(rr[0]), __uint_as_float(rr[1])); }
    float s = ((expsum16(p0, m) + expsum16(p1, m)) + (expsum16(p2, m) + expsum16(p3, m))) + ((expsum16(p4, m) + expsum16(p5, m)) + (expsum16(p6, m) + expsum16(p7, m)));
    { const auto rr = __builtin_amdgcn_permlane32_swap(__float_as_uint(s), __float_as_uint(s), false, false); s = __uint_as_float(rr[0]) + __uint_as_float(rr[1]); }
    const float inv = 1.0f / s;
    u32x4 w0, w1, w2, w3, w4, w5, w6, w7, w8, w9, w10, w11, w12, w13, w14, w15;
    pack16(p0, inv, w0, w1); pack16(p1, inv, w2, w3); pack16(p2, inv, w4, w5); pack16(p3, inv, w6, w7);
    pack16(p4, inv, w8, w9); pack16(p5, inv, w10, w11); pack16(p6, inv, w12, w13); pack16(p7, inv, w14, w15);
    CRS_WAIT_BAR(4);
    CRS_DMA_V(3, L_KB);
    const int vboff = ((lane >> 4) & 1) * 32 + (lane & 3) * 8 + (4 * hi + ((lane & 15) >> 2)) * 64;
#define CRS_BF(x) __builtin_bit_cast(bf16x8, x)
    unsigned opk[4][8];
    { f32x16 o[4];
#pragma unroll
      for (int d0 = 0; d0 < 4; ++d0) o[d0] = f32x16{};
      pv4<0>(o, (int)lds0 + L_VA + vboff, CRS_BF(w0), CRS_BF(w1), CRS_BF(w2), CRS_BF(w3));
      pv4<0>(o, (int)lds0 + L_VB + vboff, CRS_BF(w4), CRS_BF(w5), CRS_BF(w6), CRS_BF(w7));
      CRS_WAIT_BAR(4);
      pv4<0>(o, (int)lds0 + L_KA + vboff, CRS_BF(w8), CRS_BF(w9), CRS_BF(w10), CRS_BF(w11));
      CRS_WAIT_BAR(0);
      pv4<0>(o, (int)lds0 + L_KB + vboff, CRS_BF(w12), CRS_BF(w13), CRS_BF(w14), CRS_BF(w15));
#pragma unroll
      for (int d0 = 0; d0 < 4; ++d0)
#pragma unroll
          for (int k = 0; k < 8; ++k) opk[d0][k] = cvtpk(o[d0][2 * k], o[d0][2 * k + 1]); }
    f32x16 o[4];
#pragma unroll
    for (int d0 = 0; d0 < 4; ++d0) o[d0] = f32x16{};
    pv4<1>(o, (int)lds0 + L_VA + vboff, CRS_BF(w0), CRS_BF(w1), CRS_BF(w2), CRS_BF(w3));
    pv4<1>(o, (int)lds0 + L_VB + vboff, CRS_BF(w4), CRS_BF(w5), CRS_BF(w6), CRS_BF(w7));
    pv4<1>(o, (int)lds0 + L_KA + vboff, CRS_BF(w8), CRS_BF(w9), CRS_BF(w10), CRS_BF(w11));
    pv4<1>(o, (int)lds0 + L_KB + vboff, CRS_BF(w12), CRS_BF(w13), CRS_BF(w14), CRS_BF(w15));
#undef CRS_BF
    CRS_WAIT_BAR(0);
    { __attribute__((address_space(3))) unsigned short* stg = (__attribute__((address_space(3))) unsigned short*)(shm3u + wid * 16384);
      __attribute__((address_space(3))) unsigned short* stl = stg + hi * 1024 + r32;
#pragma unroll
        for (int d0 = 0; d0 < 4; ++d0)
#pragma unroll
            for (int k = 0; k < 8; ++k) { stl[crow(2 * k, 0) * 256 + d0 * 32] = (unsigned short)(opk[d0][k] & 0xffffu); stl[crow(2 * k + 1, 0) * 256 + d0 * 32] = (unsigned short)(opk[d0][k] >> 16); }
#pragma unroll
        for (int d0 = 0; d0 < 4; ++d0)
#pragma unroll
            for (int r = 0; r < 16; ++r) stl[crow(r, 0) * 256 + (4 + d0) * 32] = (unsigned short)f2bf(o[d0][r]);
        asm volatile("s_waitcnt lgkmcnt(0)" ::: "memory");
        unsigned short* Ow = Ot + (long)(wid * 32) * PITCH;
        int lofs = hi * 256 + (lane & 31) * 8; long gofs = (long)hi * PITCH + (lane & 31) * 8;
        asm volatile("" : "+v"(lofs), "+v"(gofs));
#pragma unroll
        for (int i = 0; i < 16; ++i) { const u32x4 v = *(const __attribute__((address_space(3))) u32x4*)(stg + lofs + i * 512); *(u32x4*)(Ow + gofs + (long)i * 2 * PITCH) = v; } }
    asm volatile("s_waitcnt lgkmcnt(0)\n\ts_barrier" ::: "memory");
#undef CRS_DMA_K
#undef CRS_DMA_V
#undef CRS_GLDS
}
#undef CRS_WAIT_BAR
}

constexpr int NWAVES = 8, NTHREADS = 512;
constexpr int D = 1024, SEQ = 2048, NB = 8, MP = NB * SEQ, DECB = 128, DECS = 4, MS = DECB * DECS, MT = MP + MS;
constexpr int FF = 2816, NGU = 2 * FF, NIN = 3584, NMEM = 256, MM = NB * NMEM;
constexpr int PAST = 2048, PAGE = 128, NPAGES = 16, NPOS = PAST + DECS;
constexpr float EPS = 1e-6f;
constexpr int C_QR = 0, C_KR = 512, C_VR = 1024, C_GR = 1536, C_QS = 2048, C_KS = 2560, C_VS = 3072;
constexpr size_t O_Y = 0, O_RSP = 17301504, O_SBKP = 17825792, O_SBVP = 26214400, O_MKP = 34603008, O_MVP = 36700160, O_RSS = 38797312, O_SBKS = 47185920, O_SBVS = 47448064, O_END = 47710208;
enum { I_XP = 0, I_XS, I_MEM, I_CRET, I_CSBK, I_CSBV, I_CMK, I_CMV, I_PT, I_G1PRE, I_W1G, I_W1U, I_W1D, I_G1POST, I_GMIXPRE, I_WIN, I_BSB, I_GGN, I_WOUT, I_GMIXPOST, I_GMEM, I_WMK, I_WMV, I_GXPRE, I_WXQ, I_WXO, I_GXPOST, I_G2PRE, I_W2G, I_W2U, I_W2D, I_G2POST, N_IN };

constexpr size_t MiB = 1u << 20;
constexpr size_t WS_CTL = 0, CTL_ZERO_BYTES = 1 * MiB;
constexpr size_t WS_ROPE = 1 * MiB;
constexpr size_t WS_WGU1 = 4 * MiB, WS_WD1 = 15 * MiB, WS_WIN = 21 * MiB, WS_WOUT = 28 * MiB, WS_WMKV = 30 * MiB, WS_WXQ = 34 * MiB, WS_WXO = 36 * MiB, WS_WGU2 = 38 * MiB, WS_WD2 = 49 * MiB;
constexpr size_t WS_XN = 64 * MiB, WS_MN = 97 * MiB, WS_CAT = 101 * MiB, WS_OX = 134 * MiB, WS_H = 167 * MiB, WS_C2 = 258 * MiB, WS_C3 = 324 * MiB, WS_C1 = 555 * MiB, WS_OR = 918 * MiB, WS_OS = 951 * MiB, WS_SBQ = 984 * MiB, WS_SBK = 1001 * MiB, WS_SBV = 1018 * MiB, WS_RQ = 1035 * MiB, WS_RK = 1052 * MiB, WS_RV = 1069 * MiB, WS_QXB = 1086 * MiB, WS_MKB = 1119 * MiB, WS_MVB = 1123 * MiB, WS_END = 1127 * MiB;
static_assert(WS_WD2 + (size_t)D * FF * 2 <= WS_XN && WS_XN + (size_t)MT * D * 2 <= WS_MN && WS_H + (size_t)MT * FF * 2 <= WS_C2 && WS_C2 + (size_t)MT * D * 4 <= WS_C3 && WS_C3 + (size_t)MT * NIN * 4 <= WS_C1 && WS_C1 + (size_t)MT * NGU * 4 <= WS_OR, "ws map");
constexpr int CW_TMO = 0, CW_BAR = 4096;

constexpr int RING_BYTES = 131072, LDSCTL_OFF = RING_BYTES, MISC_OFF = LDSCTL_OFF + 320, LDS_BYTES = 147456;

struct Ctx { LAS unsigned char* lds; int tid, lane, wave, gw, ngw; };
struct Args { const void* in[N_IN]; float* out; unsigned char* ws; int ph_lo, ph_hi; };
static_assert(sizeof(Args) == N_IN * 8 + 8 + 8 + 8, "Args has no padding");

__device__ __forceinline__ float wave_sum(float v) {
#pragma unroll
    for (int o = 1; o < 64; o <<= 1) v += __shfl_xor(v, o);
    return v;
}
__device__ __forceinline__ float wave_max(float v) {
#pragma unroll
    for (int o = 1; o < 64; o <<= 1) v = fmaxf(v, __shfl_xor(v, o));
    return v;
}
__device__ __forceinline__ unsigned long long pk4(f32x4 v) { return (unsigned long long)pk2(v.x, v.y) | ((unsigned long long)pk2(v.z, v.w) << 32); }

__device__ __forceinline__ void p0_transpose_item(const float* W, int K, int N, bf16* WT, int row_off, LAS float* scr, int item, int lane) {
    const int nblk = N / 32, kb = item / nblk, nb = item % nblk, k0 = 64 * kb, n0 = 32 * nb;
#pragma unroll 8
    for (int i = 0; i < 32; ++i) { const int kk = 2 * i + (lane >> 5); scr[kk * 33 + (lane & 31)] = W[(size_t)(k0 + kk) * N + n0 + (lane & 31)]; }
    LDS_WAIT(); asm volatile("" ::: "memory");
    const int c = lane & 7;
#pragma unroll
    for (int j = 0; j < 4; ++j) { const int n = (lane >> 3) + 8 * j; const LAS float* s = scr + (8 * c) * 33 + n;
        v4u o; o.x = pk2(s[0 * 33], s[1 * 33]); o.y = pk2(s[2 * 33], s[3 * 33]); o.z = pk2(s[4 * 33], s[5 * 33]); o.w = pk2(s[6 * 33], s[7 * 33]);
        *(GAS v4u*)(WT + (size_t)(row_off + n0 + n) * K + k0 + 8 * c) = o; }
    LDS_WAIT(); asm volatile("" ::: "memory");
}
__device__ __forceinline__ void rms_row_to_bf16(const float* xrow, const float* g, bf16* orow, int lane) {
    const f32x4* xr = (const f32x4*)xrow + lane; const f32x4* gr = (const f32x4*)g + lane;
    f32x4 v[4]; float s = 0.f;
#pragma unroll
    for (int j = 0; j < 4; ++j) { v[j] = xr[64 * j]; s += (v[j].x * v[j].x + v[j].y * v[j].y) + (v[j].z * v[j].z + v[j].w * v[j].w); }
    const float rstd = 1.0f / sqrtf(wave_sum(s) * (1.f / D) + EPS);
    unsigned long long* o8 = (unsigned long long*)orow + lane;
#pragma unroll
    for (int j = 0; j < 4; ++j) { const f32x4 gg = gr[64 * j]; o8[64 * j] = pk4(v[j] * rstd * gg); }
}
__device__ __forceinline__ void sincos_d(double a, double& s, double& c) {
    const double TWO_OVER_PI = 0.63661977236758134308, PIO2_HI = 1.57079632679489655800e+00, PIO2_LO = 6.12323399573676603587e-17;
    const double kf = rint(a * TWO_OVER_PI); const int k = (int)kf;
    const double r = (a - kf * PIO2_HI) - kf * PIO2_LO, r2 = r * r;
    double sp = -1.0 / 1307674368000.0; sp = sp * r2 + 1.0 / 6227020800.0; sp = sp * r2 - 1.0 / 39916800.0; sp = sp * r2 + 1.0 / 362880.0; sp = sp * r2 - 1.0 / 5040.0; sp = sp * r2 + 1.0 / 120.0; sp = sp * r2 - 1.0 / 6.0; sp = sp * r2 * r + r;
    double cp = 1.0 / 20922789888000.0; cp = cp * r2 - 1.0 / 87178291200.0; cp = cp * r2 + 1.0 / 479001600.0; cp = cp * r2 - 1.0 / 3628800.0; cp = cp * r2 + 1.0 / 40320.0; cp = cp * r2 - 1.0 / 720.0; cp = cp * r2 + 1.0 / 24.0; cp = cp * r2 - 0.5; cp = cp * r2 + 1.0;
    switch (k & 3) { case 0: s = sp; c = cp; break; case 1: s = cp; c = -sp; break; case 2: s = -sp; c = -cp; break; default: s = -cp; c = sp; break; }
}

__device__ __forceinline__ void ph_prologue(const Ctx& c, const Args& a) {
    LAS float* scr = (LAS float*)(c.lds + c.wave * 16384);
    unsigned char* ws = a.ws;
    constexpr int I_G = (D / 64) * (FF / 32), I_DN = (FF / 64) * (D / 32), I_INP = (D / 64) * (NIN / 32), I_SQ = (D / 64) * (D / 32);
    constexpr int NITEMS = 4 * I_G + 2 * I_DN + I_INP + 5 * I_SQ;
    for (int it = c.gw; it < NITEMS; it += c.ngw) {
        int r = it;
        if (r < I_G) { p0_transpose_item((const float*)a.in[I_W1G], D, FF, (bf16*)(ws + WS_WGU1), 0, scr, r, c.lane); continue; } r -= I_G;
        if (r < I_G) { p0_transpose_item((const float*)a.in[I_W1U], D, FF, (bf16*)(ws + WS_WGU1), FF, scr, r, c.lane); continue; } r -= I_G;
        if (r < I_G) { p0_transpose_item((const float*)a.in[I_W2G], D, FF, (bf16*)(ws + WS_WGU2), 0, scr, r, c.lane); continue; } r -= I_G;
        if (r < I_G) { p0_transpose_item((const float*)a.in[I_W2U], D, FF, (bf16*)(ws + WS_WGU2), FF, scr, r, c.lane); continue; } r -= I_G;
        if (r < I_DN) { p0_transpose_item((const float*)a.in[I_W1D], FF, D, (bf16*)(ws + WS_WD1), 0, scr, r, c.lane); continue; } r -= I_DN;
        if (r < I_DN) { p0_transpose_item((const float*)a.in[I_W2D], FF, D, (bf16*)(ws + WS_WD2), 0, scr, r, c.lane); continue; } r -= I_DN;
        if (r < I_INP) { p0_transpose_item((const float*)a.in[I_WIN], D, NIN, (bf16*)(ws + WS_WIN), 0, scr, r, c.lane); continue; } r -= I_INP;
        if (r < I_SQ) { p0_transpose_item((const float*)a.in[I_WOUT], D, D, (bf16*)(ws + WS_WOUT), 0, scr, r, c.lane); continue; } r -= I_SQ;
        if (r < I_SQ) { p0_transpose_item((const float*)a.in[I_WMK], D, D, (bf16*)(ws + WS_WMKV), 0, scr, r, c.lane); continue; } r -= I_SQ;
        if (r < I_SQ) { p0_transpose_item((const float*)a.in[I_WMV], D, D, (bf16*)(ws + WS_WMKV), D, scr, r, c.lane); continue; } r -= I_SQ;
        if (r < I_SQ) { p0_transpose_item((const float*)a.in[I_WXQ], D, D, (bf16*)(ws + WS_WXQ), 0, scr, r, c.lane); continue; } r -= I_SQ;
        p0_transpose_item((const float*)a.in[I_WXO], D, D, (bf16*)(ws + WS_WXO), 0, scr, r, c.lane);
    }
    float2* rope = (float2*)(ws + WS_ROPE);
    for (int idx = c.gw * 64 + c.lane; idx < NPOS * 64; idx += c.ngw * 64) {
        const int pos = idx >> 6, i = idx & 63;
        double inv = 1.0; for (int k = 0; k < i; ++k) inv *= 0.8659643233600653;
        double s, co; sincos_d((double)pos * inv, s, co);
        rope[idx] = make_float2((float)co, (float)s);
    }
    for (int m = c.gw; m < MT; m += c.ngw) {
        const float* src = m < MP ? (const float*)a.in[I_XP] + (size_t)m * D : (const float*)a.in[I_XS] + (size_t)(m - MP) * D;
        rms_row_to_bf16(src, (const float*)a.in[I_G1PRE], (bf16*)(ws + WS_XN) + (size_t)m * D, c.lane);
    }
    for (int m = c.gw; m < MM; m += c.ngw)
        rms_row_to_bf16((const float*)a.in[I_MEM] + (size_t)m * D, (const float*)a.in[I_GMEM], (bf16*)(ws + WS_MN) + (size_t)m * D, c.lane);
}

__device__ __forceinline__ void ph_swiglu(const Ctx& c, const float* C1, bf16* H) {
    constexpr int Q = FF / 4;
    const size_t total = (size_t)MT * Q;
    for (size_t idx = (size_t)blockIdx.x * NTHREADS + c.tid; idx < total; idx += (size_t)gridDim.x * NTHREADS) {
        const int r = (int)(idx / Q), q = (int)(idx % Q);
        const f32x4 g = *(const f32x4*)(C1 + (size_t)r * NGU + 4 * q), u = *(const f32x4*)(C1 + (size_t)r * NGU + FF + 4 * q);
        f32x4 h; h.x = g.x / (1.f + expf(-g.x)) * u.x; h.y = g.y / (1.f + expf(-g.y)) * u.y; h.z = g.z / (1.f + expf(-g.z)) * u.z; h.w = g.w / (1.f + expf(-g.w)) * u.w;
        *(unsigned long long*)(H + (size_t)r * FF + 4 * q) = pk4(h);
    }
}

template <bool FIRST, bool FINAL>
__device__ __forceinline__ void ph_post(const Ctx& c, const Args& a, const float* C2, float scale, const float* gpost, const float* gpre) {
    float* hout = a.out + O_Y; bf16* XN = (bf16*)(a.ws + WS_XN);
    for (int m = c.gw; m < MT; m += c.ngw) {
        const float* base = FIRST ? (m < MP ? (const float*)a.in[I_XP] + (size_t)m * D : (const float*)a.in[I_XS] + (size_t)(m - MP) * D) : hout + (size_t)m * D;
        const f32x4* cr = (const f32x4*)(C2 + (size_t)m * D) + c.lane; const f32x4* br = (const f32x4*)base + c.lane; const f32x4* g1 = (const f32x4*)gpost + c.lane;
        f32x4 v[4]; float s = 0.f;
#pragma unroll
        for (int j = 0; j < 4; ++j) { v[j] = cr[64 * j]; s += (v[j].x * v[j].x + v[j].y * v[j].y) + (v[j].z * v[j].z + v[j].w * v[j].w); }
        const float rstd = scale / sqrtf(wave_sum(s) * (1.f / D) + EPS);
        float s2 = 0.f;
#pragma unroll
        for (int j = 0; j < 4; ++j) { v[j] = br[64 * j] + v[j] * rstd * g1[64 * j]; s2 += (v[j].x * v[j].x + v[j].y * v[j].y) + (v[j].z * v[j].z + v[j].w * v[j].w); }
        f32x4* ho = (f32x4*)(hout + (size_t)m * D) + c.lane;
#pragma unroll
        for (int j = 0; j < 4; ++j) ho[64 * j] = v[j];
        if (!FINAL) {
            const float rstd2 = 1.0f / sqrtf(wave_sum(s2) * (1.f / D) + EPS);
            const f32x4* g2 = (const f32x4*)gpre + c.lane; unsigned long long* o8 = (unsigned long long*)(XN + (size_t)m * D) + c.lane;
#pragma unroll
            for (int j = 0; j < 4; ++j) o8[64 * j] = pk4(v[j] * rstd2 * g2[64 * j]);
        }
    }
}

__device__ __forceinline__ void ph_inproj_post(const Ctx& c, const Args& a) {
    float* C3 = (float*)(a.ws + WS_C3); const float2* rope = (const float2*)(a.ws + WS_ROPE);
    for (int r = c.gw; r < MT; r += c.ngw) {
        const int pos = r < MP ? (r & (SEQ - 1)) : PAST + ((r - MP) & (DECS - 1));
        float* row = C3 + (size_t)r * NIN;
        const float2 cs = rope[pos * 64 + c.lane];
#pragma unroll
        for (int h = 0; h < 4; ++h) {
            { float* p = row + C_QR + h * 128 + c.lane; const float x1 = p[0], x2 = p[64]; const float o1 = x1 * cs.x - x2 * cs.y, o2 = x1 * cs.y + x2 * cs.x; p[0] = o1; p[64] = o2;
              bf16* bq = (bf16*)(a.ws + WS_RQ) + (size_t)r * 512 + h * 128 + c.lane; bq[0] = (bf16)f2bf(o1); bq[64] = (bf16)f2bf(o2); }
            { float* p = row + C_KR + h * 128 + c.lane; const float x1 = p[0], x2 = p[64]; const float o1 = (x1 * cs.x - x2 * cs.y) * 0.08838834764831845f, o2 = (x1 * cs.y + x2 * cs.x) * 0.08838834764831845f; p[0] = o1; p[64] = o2;
              bf16* bk = (bf16*)(a.ws + WS_RK) + (size_t)r * 512 + h * 128 + c.lane; bk[0] = (bf16)f2bf(o1); bk[64] = (bf16)f2bf(o2); }
        }
        { const int col = 8 * c.lane; const f32x4 v0 = *(const f32x4*)(row + C_VR + col), v1 = *(const f32x4*)(row + C_VR + col + 4);
          unsigned long long* ov = (unsigned long long*)((bf16*)(a.ws + WS_RV) + (size_t)r * 512 + col); ov[0] = pk4(v0); ov[1] = pk4(v1); }
        float* dk = r < MP ? a.out + O_SBKP + (size_t)r * 512 : a.out + O_SBKS + (size_t)(r - MP) * 512;
        float* dv = r < MP ? a.out + O_SBVP + (size_t)r * 512 : a.out + O_SBVS + (size_t)(r - MP) * 512;
#pragma unroll
        for (int j = 0; j < 2; ++j) { ((f32x4*)dk)[c.lane + 64 * j] = ((const f32x4*)(row + C_KS))[c.lane + 64 * j]; ((f32x4*)dv)[c.lane + 64 * j] = ((const f32x4*)(row + C_VS))[c.lane + 64 * j]; }
        { const int col = 8 * c.lane; const float qs = 0.125f * 1.4426950408889634f;
          const f32x4 a0 = *(const f32x4*)(row + C_QS + col) * qs, a1 = *(const f32x4*)(row + C_QS + col + 4) * qs;
          unsigned long long* oq = (unsigned long long*)((bf16*)(a.ws + WS_SBQ) + (size_t)r * 512 + col); oq[0] = pk4(a0); oq[1] = pk4(a1);
          const f32x4 k0 = *(const f32x4*)(row + C_KS + col), k1 = *(const f32x4*)(row + C_KS + col + 4);
          unsigned long long* ok = (unsigned long long*)((bf16*)(a.ws + WS_SBK) + (size_t)r * 512 + col); ok[0] = pk4(k0); ok[1] = pk4(k1);
          const f32x4 v0 = *(const f32x4*)(row + C_VS + col), v1 = *(const f32x4*)(row + C_VS + col + 4);
          unsigned long long* ov = (unsigned long long*)((bf16*)(a.ws + WS_SBV) + (size_t)r * 512 + col); ov[0] = pk4(v0); ov[1] = pk4(v1); }
    }
}

__device__ __forceinline__ void ph_ret_naive(const Ctx& c, const Args& a) {
    constexpr int TB = 16;
    const float* C3 = (const float*)(a.ws + WS_C3); float* OR = (float*)(a.ws + WS_OR);
    const int g = c.tid >> 7, e = c.tid & 127; const int bid = blockIdx.x;
    LAS float* qk = (LAS float*)c.lds + g * (TB * 256);
    if (bid < 32) {
        retp::unit(bid >> 2, bid & 3, (const bf16*)(a.ws + WS_RQ), (const bf16*)(a.ws + WS_RK), (const bf16*)(a.ws + WS_RV), OR, a.out + O_RSP + (size_t)bid * 16384, c.lds);
    } else if (bid < 32 + DECB) {
        const int item = (bid - 32) * 4 + g, b = item >> 2, h = item & 3;
        const float gamma = 1.0f - exp2f(-5.0f - (float)h);
        const float* s0 = (const float*)a.in[I_CRET] + (size_t)item * 16384 + e;
        float S[128];
#pragma unroll
        for (int d = 0; d < 128; ++d) S[d] = s0[d * 128];
        for (int i = e; i < DECS * 256; i += 128) { const int tok = i >> 8, cc = i & 255; const float* rowp = C3 + (size_t)(MP + b * DECS + tok) * NIN;
            qk[i] = cc < 128 ? rowp[C_QR + h * 128 + cc] : rowp[C_KR + h * 128 + (cc - 128)]; }
        __syncthreads();
        for (int tok = 0; tok < DECS; ++tok) {
            const size_t row = (size_t)(MP + b * DECS + tok);
            const float v = C3[row * NIN + C_VR + h * 128 + e];
            const LAS float* qq = qk + tok * 256; float o = 0.f;
#pragma unroll
            for (int d = 0; d < 128; ++d) { S[d] = gamma * S[d] + qq[128 + d] * v; o += qq[d] * S[d]; }
            OR[row * 512 + h * 128 + e] = o;
        }
        float* so = a.out + O_RSS + (size_t)item * 16384 + e;
#pragma unroll
        for (int d = 0; d < 128; ++d) so[d * 128] = S[d];
        __syncthreads();
    }
}

__device__ __forceinline__ void ph_sb_naive(const Ctx& c, const Args& a, int first_item) {
    const float* C3 = (const float*)(a.ws + WS_C3); float* OS = (float*)(a.ws + WS_OS);
    const float* ck = (const float*)a.in[I_CSBK]; const float* cv = (const float*)a.in[I_CSBV]; const int* pt = (const int*)a.in[I_PT];
    constexpr int NPI = NB * 8 * SEQ, NSI = DECB * 8 * DECS;
    const int lane = c.lane;
    for (int it = first_item + c.gw; it < NPI + NSI; it += c.ngw) {
        int t, h, b, qrow; const bool smp = it >= NPI;
        if (!smp) { t = it & (SEQ - 1); h = (it >> 11) & 7; b = it >> 14; qrow = b * SEQ + t; }
        else { const int j = it - NPI; const int i = j & 3; h = (j >> 2) & 7; b = j >> 5; t = PAST + i; qrow = MP + b * DECS + i; }
        const float bias = ((const float*)a.in[I_BSB])[h];
        const f32x4* qp = (const f32x4*)(C3 + (size_t)qrow * NIN + C_QS + h * 64);
        f32x4 q[16], acc[16];
#pragma unroll
        for (int i = 0; i < 16; ++i) { q[i] = qp[i]; acc[i] = (f32x4){0.f, 0.f, 0.f, 0.f}; }
        float carry = 0.f;
        for (int s0 = t - 1; s0 >= 0; s0 -= 64) {
            const int s = s0 - lane; const bool valid = s >= 0;
            const float* kp = C3 + C_KS + h * 64; const float* vp = C3 + C_VS + h * 64;
            if (valid) {
                if (!smp) { kp = C3 + (size_t)(b * SEQ + s) * NIN + C_KS + h * 64; vp = kp + (C_VS - C_KS); }
                else if (s >= PAST) { kp = C3 + (size_t)(MP + b * DECS + (s - PAST)) * NIN + C_KS + h * 64; vp = kp + (C_VS - C_KS); }
                else { const int pg = pt[b * NPAGES + (s >> 7)]; const size_t off = ((size_t)pg * PAGE + (s & (PAGE - 1))) * 512 + h * 64; kp = ck + off; vp = cv + off; }
            }
            float z = 0.f;
#pragma unroll
            for (int i = 0; i < 16; ++i) { const f32x4 kk = ((const f32x4*)kp)[i]; z += (q[i].x * kk.x + q[i].y * kk.y) + (q[i].z * kk.z + q[i].w * kk.w); }
            z = z * 0.125f + bias;
            const float sp = fmaxf(z, 0.f) + log1pf(expf(-fabsf(z)));
            const float lsn = valid ? -sp : 0.f;
            float inc = lsn;
#pragma unroll
            for (int o = 1; o < 64; o <<= 1) { const float y = __shfl_up(inc, o); if (lane >= o) inc += y; }
            const float later = carry + (inc - lsn);
            const float av = valid ? expf((z - sp) + later) : 0.f;
            carry += __shfl(inc, 63);
#pragma unroll
            for (int i = 0; i < 16; ++i) { const f32x4 vv = ((const f32x4*)vp)[i]; acc[i] += av * vv; }
        }
        float outv = 0.f;
#pragma unroll
        for (int i = 0; i < 16; ++i) {
            const float r0 = wave_sum(acc[i].x), r1 = wave_sum(acc[i].y), r2 = wave_sum(acc[i].z), r3 = wave_sum(acc[i].w);
            if (lane == 4 * i) outv = r0; if (lane == 4 * i + 1) outv = r1; if (lane == 4 * i + 2) outv = r2; if (lane == 4 * i + 3) outv = r3;
        }
        OS[(size_t)qrow * 512 + h * 64 + lane] = outv;
    }
}

__device__ __forceinline__ void ph_mixout(const Ctx& c, const Args& a) {
    const float* C3 = (const float*)(a.ws + WS_C3); const float* OR = (const float*)(a.ws + WS_OR); const float* OS = (const float*)(a.ws + WS_OS); bf16* CAT = (bf16*)(a.ws + WS_CAT);
    const float* ggn = (const float*)a.in[I_GGN];
    for (int r = c.gw; r < MT; r += c.ngw) {
        const int col = 8 * c.lane;
        const f32x4 x0 = *(const f32x4*)(OR + (size_t)r * 512 + col), x1 = *(const f32x4*)(OR + (size_t)r * 512 + col + 4);
        float s = (x0.x + x0.y) + (x0.z + x0.w) + (x1.x + x1.y) + (x1.z + x1.w);
        s += __shfl_xor(s, 1); s += __shfl_xor(s, 2); s += __shfl_xor(s, 4); s += __shfl_xor(s, 8);
        const float mu = s * (1.f / 128.f);
        const f32x4 d0 = x0 - mu, d1 = x1 - mu;
        float q = (d0.x * d0.x + d0.y * d0.y) + (d0.z * d0.z + d0.w * d0.w) + (d1.x * d1.x + d1.y * d1.y) + (d1.z * d1.z + d1.w * d1.w);
        q += __shfl_xor(q, 1); q += __shfl_xor(q, 2); q += __shfl_xor(q, 4); q += __shfl_xor(q, 8);
        const float rstd = 1.0f / sqrtf(q * (1.f / 128.f) + EPS);
        const f32x4 g0 = *(const f32x4*)(ggn + col), g1 = *(const f32x4*)(ggn + col + 4);
        const f32x4 r0 = *(const f32x4*)(C3 + (size_t)r * NIN + C_GR + col), r1 = *(const f32x4*)(C3 + (size_t)r * NIN + C_GR + col + 4);
        f32x4 y0, y1;
        y0.x = d0.x * rstd * g0.x * (r0.x / (1.f + expf(-r0.x))); y0.y = d0.y * rstd * g0.y * (r0.y / (1.f + expf(-r0.y))); y0.z = d0.z * rstd * g0.z * (r0.z / (1.f + expf(-r0.z))); y0.w = d0.w * rstd * g0.w * (r0.w / (1.f + expf(-r0.w)));
        y1.x = d1.x * rstd * g1.x * (r1.x / (1.f + expf(-r1.x))); y1.y = d1.y * rstd * g1.y * (r1.y / (1.f + expf(-r1.y))); y1.z = d1.z * rstd * g1.z * (r1.z / (1.f + expf(-r1.z))); y1.w = d1.w * rstd * g1.w * (r1.w / (1.f + expf(-r1.w)));
        unsigned long long* o = (unsigned long long*)(CAT + (size_t)r * D + col); o[0] = pk4(y0); o[1] = pk4(y1);
        if (r >= MP) { const f32x4 s0 = *(const f32x4*)(OS + (size_t)r * 512 + col), s1 = *(const f32x4*)(OS + (size_t)r * 512 + col + 4);
        unsigned long long* o2 = (unsigned long long*)(CAT + (size_t)r * D + 512 + col); o2[0] = pk4(s0); o2[1] = pk4(s1); }
    }
}

__device__ __forceinline__ void ph_cross(const Ctx& c, const Args& a) {
    const bf16* QX = (const bf16*)(a.ws + WS_QXB); bf16* OX = (bf16*)(a.ws + WS_OX);
    if (blockIdx.x < 256) { const int u = (int)blockIdx.x;
        const int tile = u >> 2, head = u & 3, b = tile >> 3;
        crs::unit(QX + (size_t)tile * 256 * D + head * 256, (const bf16*)(a.ws + WS_MKB) + (size_t)b * NMEM * D + head * 256, (const bf16*)(a.ws + WS_MVB) + (size_t)b * NMEM * D + head * 256,
                  OX + (size_t)tile * 256 * D + head * 256, c.lds);
    }
    __syncthreads();
    LAS float* qs = (LAS float*)(c.lds + c.wave * 2048); LAS float* ps = qs + 256;
    const int lane = c.lane;
    for (int it = MP * 4 + c.gw; it < MT * 4; it += c.ngw) {
        const int r = it >> 2, h = it & 3;
        const int b = (r - MP) >> 2; const float* Kb = (const float*)a.in[I_CMK] + (size_t)b * NMEM * D; const float* Vb = (const float*)a.in[I_CMV] + (size_t)b * NMEM * D;
        { const unsigned long long q4 = *(const unsigned long long*)(QX + (size_t)r * D + h * 256 + 4 * lane); const unsigned lo = (unsigned)q4, hi2 = (unsigned)(q4 >> 32);
          *(LAS f32x4*)(qs + 4 * lane) = (f32x4){__uint_as_float(lo << 16), __uint_as_float(lo & 0xffff0000u), __uint_as_float(hi2 << 16), __uint_as_float(hi2 & 0xffff0000u)}; }
        LDS_WAIT(); asm volatile("" ::: "memory");
        float sc[4];
#pragma unroll
        for (int j = 0; j < 4; ++j) { const int m = lane + 64 * j; const f32x4* kp = (const f32x4*)(Kb + (size_t)m * D + h * 256); float s = 0.f;
#pragma unroll 8
            for (int d4 = 0; d4 < 64; ++d4) { const f32x4 kk = kp[d4]; const f32x4 qq = *(const LAS f32x4*)(qs + 4 * d4); s += (kk.x * qq.x + kk.y * qq.y) + (kk.z * qq.z + kk.w * qq.w); }
            sc[j] = s; }
        const float mx = wave_max(fmaxf(fmaxf(sc[0], sc[1]), fmaxf(sc[2], sc[3])));
        float p[4], sum = 0.f;
#pragma unroll
        for (int j = 0; j < 4; ++j) { p[j] = exp2f(sc[j] - mx); sum += p[j]; }
        const float inv = 1.0f / wave_sum(sum);
#pragma unroll
        for (int j = 0; j < 4; ++j) ps[lane + 64 * j] = p[j] * inv;
        LDS_WAIT(); asm volatile("" ::: "memory");
        f32x4 o = (f32x4){0.f, 0.f, 0.f, 0.f};
#pragma unroll 8
        for (int m = 0; m < NMEM; ++m) { const float pm = ps[m]; const f32x4 vv = *(const f32x4*)(Vb + (size_t)m * D + h * 256 + 4 * lane); o += pm * vv; }
        *(unsigned long long*)(OX + (size_t)r * D + h * 256 + 4 * lane) = pk4(o);
        LDS_WAIT(); asm volatile("" ::: "memory");
    }
}

__device__ __forceinline__ void ph_gemm_f32(const Ctx& c, const bf16* A, const bf16* Bt, int M, int N, int K, float* C, int ldc, int split_cols, size_t split_stride, int cid) {
    pg8::Gemm g{A, Bt, M, N, K}; pg8::StaticOrder S; S.init(M, N, (int)gridDim.x, cid);
    pg8::EpiF32 E{C, ldc, split_cols, split_stride};
    pg8::gemm_phase<pg8::EpiF32, pg8::StaticOrder, true, true>(c.lds, g, S, E);
}

__device__ __forceinline__ void ph_gemm_f32b(const Ctx& c, const bf16* A, const bf16* Bt, int M, int N, int K, float* C, bf16* Cb, int ldc, int split_cols, size_t split_stride, size_t split_stride_b, int cid) {
    pg8::Gemm g{A, Bt, M, N, K}; pg8::StaticOrder S; S.init(M, N, (int)gridDim.x, cid);
    pg8::EpiF32B E{C, Cb, ldc, split_cols, split_stride, split_stride_b};
    pg8::gemm_phase<pg8::EpiF32B, pg8::StaticOrder, true, true>(c.lds, g, S, E);
}
__device__ __forceinline__ void ph_gemm_bf16(const Ctx& c, const bf16* A, const bf16* Bt, int M, int N, int K, bf16* O, int ldc, float scale, int cid) {
    pg8::Gemm g{A, Bt, M, N, K}; pg8::StaticOrder S; S.init(M, N, (int)gridDim.x, cid);
    pg8::EpiBf16<0> E{O, ldc, nullptr, N, 0, scale};
    pg8::gemm_phase<pg8::EpiBf16<0>, pg8::StaticOrder, true, true>(c.lds, g, S, E);
}

constexpr int NPH = 19;
__global__ void __launch_bounds__(NTHREADS, 2) fwd(Args args) {
    extern __shared__ __attribute__((aligned(16))) unsigned char lds_raw[];
    Ctx c; c.lds = (LAS unsigned char*)lds_raw; c.tid = threadIdx.x; c.lane = c.tid & 63; c.wave = __builtin_amdgcn_readfirstlane(c.tid >> 6);
    c.gw = blockIdx.x * NWAVES + c.wave; c.ngw = gridDim.x * NWAVES;
    volatile LAS unsigned* MISC = (volatile LAS unsigned*)(c.lds + MISC_OFF);
    for (int u = c.tid; u < (LDS_BYTES - LDSCTL_OFF) / 4; u += NTHREADS) ((LAS unsigned*)(c.lds + LDSCTL_OFF))[u] = 0u;
    __syncthreads();
    unsigned char* ws = args.ws;
    const int lo = args.ph_lo, hi = args.ph_hi;
    const bool multi = (hi - lo) > 1;
    XcdBarrier bar; bar.bar = (unsigned*)(ws + WS_CTL) + CW_BAR; bar.x = 0; bar.st = nullptr;
    if (multi) bar = xcd_barrier_post((unsigned*)(ws + WS_CTL) + CW_BAR, MISC + 8);
#define IN(k) (lo <= (k) && (k) < hi)
#define SEAM(k) do { if (IN(k) && IN((k) + 1)) xcd_barrier(bar); } while (0)
    bf16* XN = (bf16*)(ws + WS_XN); bf16* H = (bf16*)(ws + WS_H); float* C1 = (float*)(ws + WS_C1); float* C2 = (float*)(ws + WS_C2); float* C3 = (float*)(ws + WS_C3);
    const int cid = (int)blockIdx.x;

    if (IN(0)) { ph_prologue(c, args); } SEAM(0);
    if (IN(1)) { ph_gemm_f32(c, XN, (const bf16*)(ws + WS_WGU1), MT, NGU, D, C1, NGU, 0, 0, cid);
                 ph_gemm_f32b(c, (const bf16*)(ws + WS_MN), (const bf16*)(ws + WS_WMKV), MM, 2 * D, D, args.out + O_MKP, (bf16*)(ws + WS_MKB), D, D, (size_t)(O_MVP - O_MKP), (size_t)(WS_MVB - WS_MKB) / 2, (cid + 84) & 255); } SEAM(1);
    if (IN(2)) { ph_swiglu(c, C1, H); } SEAM(2);
    if (IN(3)) { ph_gemm_f32(c, H, (const bf16*)(ws + WS_WD1), MT, D, FF, C2, D, 0, 0, cid); } SEAM(3);
    if (IN(4)) { ph_post<true, false>(c, args, C2, 0.5f, (const float*)args.in[I_G1POST], (const float*)args.in[I_GMIXPRE]); } SEAM(4);
    if (IN(5)) { ph_gemm_f32(c, XN, (const bf16*)(ws + WS_WIN), MT, NIN, D, C3, NIN, 0, 0, cid); } SEAM(5);
    if (IN(6)) { ph_inproj_post(c, args); } SEAM(6);
    if (IN(7)) { ph_ret_naive(c, args); __syncthreads();
                 { const int vcu = (int)blockIdx.x, bh = vcu >> 2, sq = vcu & 3; const float bias2 = ((const float*)args.in[I_BSB])[bh & 7] * 1.4426950408889634f;
                   const bf16* SQ = (const bf16*)(ws + WS_SBQ); const bf16* SK = (const bf16*)(ws + WS_SBK); const bf16* SV = (const bf16*)(ws + WS_SBV); bf16* OC = (bf16*)(ws + WS_CAT) + 512;
                   if (vcu < 256) { sbp::unit(bh >> 3, bh & 7, 7 - sq, SQ, SK, SV, OC, bias2, c.lds); sbp::unit(bh >> 3, bh & 7, sq, SQ, SK, SV, OC, bias2, c.lds); } }
                 ph_sb_naive(c, args, NB * 8 * SEQ); } SEAM(7);
    if (IN(8)) { ph_mixout(c, args); } SEAM(8);
    if (IN(9)) { ph_gemm_f32(c, (const bf16*)(ws + WS_CAT), (const bf16*)(ws + WS_WOUT), MT, D, D, C2, D, 0, 0, cid); } SEAM(9);
    if (IN(10)) { ph_post<false, false>(c, args, C2, 1.0f, (const float*)args.in[I_GMIXPOST], (const float*)args.in[I_GXPRE]); } SEAM(10);
    if (IN(11)) { ph_gemm_bf16(c, XN, (const bf16*)(ws + WS_WXQ), MT, D, D, (bf16*)(ws + WS_QXB), D, 0.0625f * 1.4426950408889634f, cid); } SEAM(11);
    if (IN(12)) { ph_cross(c, args); } SEAM(12);
    if (IN(13)) { ph_gemm_f32(c, (const bf16*)(ws + WS_OX), (const bf16*)(ws + WS_WXO), MT, D, D, C2, D, 0, 0, cid); } SEAM(13);
    if (IN(14)) { ph_post<false, false>(c, args, C2, 1.0f, (const float*)args.in[I_GXPOST], (const float*)args.in[I_G2PRE]); } SEAM(14);
    if (IN(15)) { ph_gemm_f32(c, XN, (const bf16*)(ws + WS_WGU2), MT, NGU, D, C1, NGU, 0, 0, cid); } SEAM(15);
    if (IN(16)) { ph_swiglu(c, C1, H); } SEAM(16);
    if (IN(17)) { ph_gemm_f32(c, H, (const bf16*)(ws + WS_WD2), MT, D, FF, C2, D, 0, 0, cid); } SEAM(17);
    if (IN(18)) { ph_post<false, true>(c, args, C2, 0.5f, (const float*)args.in[I_G2POST], nullptr); }
#undef IN
#undef SEAM
}

#ifndef MK_ONE_LAUNCH
#define MK_ONE_LAUNCH 1
#endif
extern "C" void kernel_launch(void* const* d_in, const int* in_sizes, int n_in, void* d_out, int out_size, void* d_ws, size_t ws_size, hipStream_t stream) {
    static int grid = 0;
    if (grid == 0) {
        if (n_in != N_IN || (size_t)out_size != O_END || ws_size < WS_END) { fprintf(stderr, "kernel_launch: unexpected shapes: n_in %d out %d ws %zu; nothing launched\n", n_in, out_size, ws_size); grid = -1; return; }
        int dev = 0, cus = 0, per_cu = 0;
        if (hipGetDevice(&dev) != hipSuccess || hipDeviceGetAttribute(&cus, hipDeviceAttributeMultiprocessorCount, dev) != hipSuccess) { grid = -1; return; }
        if (hipFuncSetAttribute((const void*)fwd, hipFuncAttributeMaxDynamicSharedMemorySize, LDS_BYTES) != hipSuccess) { fprintf(stderr, "kernel_launch: hipFuncSetAttribute failed\n"); grid = -1; return; }
        if (hipOccupancyMaxActiveBlocksPerMultiprocessor(&per_cu, (const void*)fwd, NTHREADS, LDS_BYTES) != hipSuccess || per_cu < 1) fprintf(stderr, "kernel_launch: occupancy query reports %d\n", per_cu);
        (void)hipGetLastError();
        grid = cus;
        if (grid != 256) fprintf(stderr, "kernel_launch: %d CUs (expected 256)\n", grid);
    }
    if (grid < 0) return;
    if (hipMemsetAsync((char*)d_ws + WS_CTL, 0, CTL_ZERO_BYTES, stream) != hipSuccess) return;
    Args a{};
    for (int i = 0; i < N_IN; ++i) a.in[i] = d_in[i];
    a.out = (float*)d_out; a.ws = (unsigned char*)d_ws;
#if MK_ONE_LAUNCH
    a.ph_lo = 0; a.ph_hi = NPH;
    hipLaunchKernelGGL(fwd, dim3(grid), dim3(NTHREADS), LDS_BYTES, stream, a);
#else
    for (int p = 0; p < NPH; ++p) { a.ph_lo = p; a.ph_hi = p + 1; hipLaunchKernelGGL(fwd, dim3(grid), dim3(NTHREADS), LDS_BYTES, stream, a); }
#endif
}
```

```cpp
#include <hip/hip_runtime.h>
#include <cstdio>
#include <cstdint>
namespace pg8 {
#define PG8_LAS __attribute__((address_space(3)))
typedef unsigned short bf16_t;
typedef short bf16x8 __attribute__((ext_vector_type(8)));
typedef float f32x4 __attribute__((ext_vector_type(4)));
typedef unsigned u32x4 __attribute__((ext_vector_type(4)));
constexpr int BM = 256, BK = 64, HALF = 128, HTB = HALF * BK * 2  , STAGE_BYTES = 8 * HTB, NXCD = 8, WGM = 8;

__host__ __device__ __forceinline__ int lds_byte(int r, int c) { const int st = (r >> 4) * 2 + (c >> 5), rr = r & 15, cc = c & 31, ob = rr * 64 + cc * 2; return st * 1024 + (ob ^ (((ob >> 9) & 1) << 5)); }
__host__ __device__ __forceinline__ void stage_rc(int b, int& R, int& C) { const int st = b / 1024, sb = b % 1024, swz = sb ^ (((sb >> 9) & 1) << 5); R = (st >> 1) * 16 + swz / 64; C = (st & 1) * 32 + (swz % 64) / 2; }
__host__ __device__ __forceinline__ int perm32(int rho) { const int n = rho >> 4, i = rho & 15; return 8 * (i >> 2) + 4 * n + (i & 3); }

struct Unit { int pm, pn; };
struct Gemm { const bf16_t* A; const bf16_t* Bt; int M, N, K; };

struct StaticOrder {
    int nM, nN, nwg, G, c;
    __host__ __device__ void init(int M, int N, int G_, int c_) { nM = M / BM; nN = N / BM; nwg = nM * nN; G = G_; c = c_; }
    __host__ __device__ bool next(int i, Unit& u) const {
        const long L = (long)i * G + c; if (L >= nwg) return false;
        int wgid = (int)L; { const int q = nwg / NXCD, r = nwg % NXCD, xcd = wgid % NXCD, off = wgid / NXCD; wgid = (xcd < r ? xcd * (q + 1) : r * (q + 1) + (xcd - r) * q) + off; }
        const int nig = WGM * nN, gid = wgid / nig, fm = gid * WGM, gsz = (nM - fm) < WGM ? (nM - fm) : WGM;
        u.pm = fm + ((wgid % nig) % gsz); u.pn = (wgid % nig) / gsz; return true;
    }
    __device__ __forceinline__ void a_ready(const Unit&) const {}
    __device__ __forceinline__ void done(const Unit&) const {}
};

__device__ __forceinline__ unsigned cvt_pk_bf16(float lo, float hi) { unsigned r; asm volatile("v_cvt_pk_bf16_f32 %0, %1, %2" : "=v"(r) : "v"(lo), "v"(hi)); return r; }
typedef float f32x2 __attribute__((ext_vector_type(2)));
__device__ __forceinline__ f32x2 gelu_pk(f32x2 v) {
    const f32x2 av = __builtin_elementwise_abs(v), d = av * 0.2316418882f + 1.0f;
    f32x2 t; t.x = __builtin_amdgcn_rcpf(d.x); t.y = __builtin_amdgcn_rcpf(d.y);
    f32x2 q = t * 0.5307027145f + (-0.7265760135f); q = q * t + 0.7107068705f; q = q * t + (-0.142248368f); q = q * t + 0.127414796f; q = q * t;
    const f32x2 s = (v * v) * (-0.72134752044f);
    f32x2 e; e.x = __builtin_amdgcn_exp2f(s.x); e.y = __builtin_amdgcn_exp2f(s.y);
    const f32x2 m = v * (q * e), r = v - m;
    f32x2 o; o.x = v.x < 0.f ? m.x : r.x; o.y = v.y < 0.f ? m.y : r.y; return o;
}

template <int ACT  > struct EpiBf16 {
    static constexpr bool PERM = true, AFTER_DRAIN = false; static_assert(ACT == 0 || ACT == 1, "EpiBf16: ACT is 0 (none) or 1 (gelu_pk)");
    bf16_t* O; int ldc; const float* bias; int split_cols; size_t split_stride; float scale0;
    __device__ __forceinline__ void operator()(const f32x4 (&acc)[2][2][4][2], const Unit& u, int wr, int wc, int fr, int fq) const {
        const int row0 = u.pm * BM + wr * 64 + fr; int colt = u.pn * BM; bf16_t* base = O;
        float sc = 1.f; if (split_cols) { const int t = colt / split_cols; base += (size_t)t * split_stride; colt -= t * split_cols; if (t == 0) sc = scale0; }
        const int col0 = colt + wc * 32 + 8 * fq, bcol0 = u.pn * BM + wc * 32 + 8 * fq;
        f32x4 bv[2][2];
#pragma unroll
        for (int bj = 0; bj < 2; ++bj)
#pragma unroll
            for (int n = 0; n < 2; ++n) bv[bj][n] = bias ? *(const f32x4*)(bias + bcol0 + bj * HALF + 4 * n) : (f32x4){0.f, 0.f, 0.f, 0.f};
#pragma unroll
        for (int ai = 0; ai < 2; ++ai)
#pragma unroll
            for (int m = 0; m < 4; ++m) { bf16_t* rowp = base + (size_t)(row0 + ai * HALF + m * 16) * ldc + col0;
#pragma unroll
                for (int bj = 0; bj < 2; ++bj) { f32x4 v0 = acc[ai][bj][m][0] + bv[bj][0], v1 = acc[ai][bj][m][1] + bv[bj][1];
                    if (ACT == 1) { f32x2 a = gelu_pk((f32x2){v0[0], v0[1]}), b = gelu_pk((f32x2){v0[2], v0[3]}), c = gelu_pk((f32x2){v1[0], v1[1]}), d = gelu_pk((f32x2){v1[2], v1[3]});
                        v0 = (f32x4){a.x, a.y, b.x, b.y}; v1 = (f32x4){c.x, c.y, d.x, d.y}; }
                    v0 = v0 * sc; v1 = v1 * sc; u32x4 w; w.x = cvt_pk_bf16(v0[0], v0[1]); w.y = cvt_pk_bf16(v0[2], v0[3]); w.z = cvt_pk_bf16(v1[0], v1[1]); w.w = cvt_pk_bf16(v1[2], v1[3]);
                    *(u32x4*)(rowp + bj * HALF) = w; } }
    }
};
struct EpiF32 {
    static constexpr bool PERM = false, AFTER_DRAIN = false;
    float* C; int ldc; int split_cols; size_t split_stride;
    __device__ __forceinline__ void operator()(const f32x4 (&acc)[2][2][4][2], const Unit& u, int wr, int wc, int fr, int fq) const {
        int colt = u.pn * BM; float* base = C;
        if (split_cols) { const int t = colt / split_cols; base += (size_t)t * split_stride; colt -= t * split_cols; }
        const int row0 = u.pm * BM + wr * 64 + fr, col0 = colt + wc * 32 + 4 * fq;
#pragma unroll
        for (int ai = 0; ai < 2; ++ai)
#pragma unroll
            for (int m = 0; m < 4; ++m) { float* rowp = base + (size_t)(row0 + ai * HALF + m * 16) * ldc + col0;
#pragma unroll
                for (int bj = 0; bj < 2; ++bj)
#pragma unroll
                    for (int n = 0; n < 2; ++n) *(f32x4*)(rowp + bj * HALF + n * 16) = acc[ai][bj][m][n]; }
    }
};
struct EpiF32B {
    static constexpr bool PERM = false, AFTER_DRAIN = false;
    float* C; bf16_t* Cb; int ldc; int split_cols; size_t split_stride, split_stride_b;
    __device__ __forceinline__ void operator()(const f32x4 (&acc)[2][2][4][2], const Unit& u, int wr, int wc, int fr, int fq) const {
        int colt = u.pn * BM; float* base = C; bf16_t* baseb = Cb;
        if (split_cols) { const int t = colt / split_cols; base += (size_t)t * split_stride; baseb += (size_t)t * split_stride_b; colt -= t * split_cols; }
        const int row0 = u.pm * BM + wr * 64 + fr, col0 = colt + wc * 32 + 4 * fq;
        typedef unsigned u32x2v __attribute__((ext_vector_type(2)));
#pragma unroll
        for (int ai = 0; ai < 2; ++ai)
#pragma unroll
            for (int m = 0; m < 4; ++m) { const size_t off = (size_t)(row0 + ai * HALF + m * 16) * ldc + col0;
#pragma unroll
                for (int bj = 0; bj < 2; ++bj)
#pragma unroll
                    for (int n = 0; n < 2; ++n) { const f32x4 v = acc[ai][bj][m][n]; *(f32x4*)(base + off + bj * HALF + n * 16) = v;
                        u32x2v w; w.x = cvt_pk_bf16(v[0], v[1]); w.y = cvt_pk_bf16(v[2], v[3]); *(u32x2v*)(baseb + off + bj * HALF + n * 16) = w; } }
    }
};
struct EpiSwiglu {
    static constexpr bool PERM = true, AFTER_DRAIN = false;
    bf16_t* O; int ldc;
    __device__ __forceinline__ void operator()(const f32x4 (&acc)[2][2][4][2], const Unit& u, int wr, int wc, int fr, int fq) const {
        const int row0 = u.pm * BM + wr * 64 + fr, col0 = u.pn * HALF + wc * 32 + 8 * fq;
#pragma unroll
        for (int ai = 0; ai < 2; ++ai)
#pragma unroll
            for (int m = 0; m < 4; ++m) { bf16_t* rowp = O + (size_t)(row0 + ai * HALF + m * 16) * ldc + col0;
                float h[8];
#pragma unroll
                for (int n = 0; n < 2; ++n)
#pragma unroll
                    for (int j = 0; j < 4; ++j) { const float g = acc[ai][0][m][n][j], up = acc[ai][1][m][n][j];
                        const float e = __builtin_amdgcn_exp2f(-1.4426950408889634f * g); h[4 * n + j] = g * up * __builtin_amdgcn_rcpf(1.0f + e); }
                u32x4 w; w.x = cvt_pk_bf16(h[0], h[1]); w.y = cvt_pk_bf16(h[2], h[3]); w.z = cvt_pk_bf16(h[4], h[5]); w.w = cvt_pk_bf16(h[6], h[7]);
                *(u32x4*)rowp = w; }
    }
};
template <class Epi, class Sched, bool ALIGN_EPI = false, bool SP2 = false>
__device__ __forceinline__ void gemm_phase(PG8_LAS unsigned char* lds, const Gemm g, const Sched& S, const Epi& E) {
    const int tid = threadIdx.x, wid = __builtin_amdgcn_readfirstlane(tid >> 6), lane = tid & 63, wr = wid >> 2, wc = wid & 3, fr = lane & 15, fq = lane >> 4;
    const int K = g.K, nt = K / BK;
    unsigned voffA[2], voffB[2];
#pragma unroll
    for (int i = 0; i < 2; ++i) { int R, C; stage_rc(tid * 16 + i * 8192, R, C); const int Rb = Epi::PERM ? ((R & ~31) + perm32(R & 31)) : R;
        voffA[i] = (unsigned)(R * K + C) * 2u; voffB[i] = (unsigned)(Rb * K + C) * 2u; }
    const size_t kstep = (size_t)(BK * 2);
    const size_t hstep = (size_t)HALF * K * 2;
    const size_t tstep = 2 * hstep;
    const unsigned ldsw = (unsigned)wid * 1024u;
    const int aoff = lds_byte(wr * 64 + fr, fq * 8), boff = lds_byte(wc * 32 + fr, fq * 8);
#define PG8_SA(b, h) (((b) * 2 + (h)) * HTB)
#define PG8_SB(b, h) ((4 + (b) * 2 + (h)) * HTB)
#define PG8_STAGE(bufoff, gbase, voff) do { _Pragma("unroll") for (int _i = 0; _i < 2; ++_i) \
        __builtin_amdgcn_global_load_lds((const unsigned*)((const char*)(gbase) + (voff)[_i]), (PG8_LAS unsigned*)(lds + (bufoff) + ldsw + _i * 8192), 16, 0, 0); } while (0)
#define PG8_LDA(dst, b, h) do { _Pragma("unroll") for (int m = 0; m < 4; ++m) _Pragma("unroll") for (int k = 0; k < 2; ++k) dst[m][k] = *(const PG8_LAS bf16x8*)(lds + PG8_SA(b, h) + aoff + m * 2048 + k * 1024); } while (0)
#define PG8_LDB(dst, b, h) do { _Pragma("unroll") for (int n = 0; n < 2; ++n) _Pragma("unroll") for (int k = 0; k < 2; ++k) dst[n][k] = *(const PG8_LAS bf16x8*)(lds + PG8_SB(b, h) + boff + n * 2048 + k * 1024); } while (0)
#define PG8_MMA(ai, bj, At, Bt) do { __builtin_amdgcn_s_setprio(1); _Pragma("unroll") for (int m = 0; m < 4; ++m) _Pragma("unroll") for (int n = 0; n < 2; ++n) _Pragma("unroll") for (int k = 0; k < 2; ++k) \
        acc[ai][bj][m][n] = __builtin_amdgcn_mfma_f32_16x16x32_bf16(Bt[n][k], At[m][k], acc[ai][bj][m][n], 0, 0, 0); __builtin_amdgcn_s_setprio(0); } while (0)
#define PG8_WAIT_V(n) asm volatile("s_waitcnt vmcnt(" #n ")" ::: "memory")
#define PG8_WAIT_L(n) asm volatile("s_waitcnt lgkmcnt(" #n ")" ::: "memory")
#define PG8_BAR __builtin_amdgcn_s_barrier()
#define PG8_SCHED __builtin_amdgcn_sched_barrier(0)
    Unit cur, nxt; int ui = 0;
    if (!S.next(0, cur)) return;
    f32x4 acc[2][2][4][2];
#pragma unroll
    for (int a = 0; a < 2; ++a)
#pragma unroll
        for (int b = 0; b < 2; ++b)
#pragma unroll
            for (int m = 0; m < 4; ++m)
#pragma unroll
                for (int n = 0; n < 2; ++n) acc[a][b][m][n] = (f32x4){0.f, 0.f, 0.f, 0.f};
    bf16x8 At[4][2], B0[2][2], B1[2][2];
    const char* cA = (const char*)g.A + (size_t)cur.pm * tstep; const char* cB = (const char*)g.Bt + (size_t)cur.pn * tstep;
    S.a_ready(cur);
    if constexpr (SP2) {
        PG8_STAGE(PG8_SB(0, 0), cB, voffB); PG8_STAGE(PG8_SB(0, 1), cB + hstep, voffB); PG8_STAGE(PG8_SA(0, 0), cA, voffA); PG8_STAGE(PG8_SA(0, 1), cA + hstep, voffA);
        if (wr == 1) PG8_BAR;
        PG8_WAIT_V(2); PG8_BAR;
        PG8_STAGE(PG8_SB(1, 0), cB + kstep, voffB); PG8_STAGE(PG8_SA(1, 0), cA + kstep, voffA); PG8_STAGE(PG8_SB(1, 1), cB + hstep + kstep, voffB);
        PG8_WAIT_V(6); PG8_BAR;
    } else {
        PG8_STAGE(PG8_SB(0, 0), cB, voffB); PG8_STAGE(PG8_SA(0, 0), cA, voffA); PG8_STAGE(PG8_SB(0, 1), cB + hstep, voffB); PG8_STAGE(PG8_SA(0, 1), cA + hstep, voffA);
        if (wr == 1) PG8_BAR;
        PG8_WAIT_V(4); PG8_BAR;
        PG8_STAGE(PG8_SB(1, 0), cB + kstep, voffB); PG8_STAGE(PG8_SA(1, 0), cA + kstep, voffA); PG8_STAGE(PG8_SB(1, 1), cB + hstep + kstep, voffB);
        PG8_WAIT_V(6); PG8_BAR;
    }
    for (;;) {
        const bool has_next = S.next(ui + 1, nxt);
        const char* nA = has_next ? (const char*)g.A + (size_t)nxt.pm * tstep : cA; const char* nB = has_next ? (const char*)g.Bt + (size_t)nxt.pn * tstep : cB;
        for (int t = 0; t < nt; t += 2) {
            const bool last = (t == nt - 2);
            const char* a1 = cA + (size_t)(t + 1) * kstep;
            const char* a2 = last ? nA : cA + (size_t)(t + 2) * kstep; const char* b2 = last ? nB : cB + (size_t)(t + 2) * kstep;
            const char* a3 = a2 + kstep; const char* b3 = b2 + kstep;
            if (last && has_next) S.a_ready(nxt);
            if constexpr (SP2) {
            PG8_LDB(B0, 0, 0); PG8_LDB(B1, 0, 1); PG8_SCHED; PG8_LDA(At, 0, 0); PG8_STAGE(PG8_SA(1, 1), a1 + hstep, voffA);
            PG8_WAIT_V(8); PG8_WAIT_L(0); PG8_BAR; PG8_MMA(0, 0, At, B0); PG8_MMA(0, 1, At, B1); PG8_BAR; PG8_SCHED;
            PG8_LDA(At, 0, 1); PG8_STAGE(PG8_SB(0, 0), b2, voffB); PG8_STAGE(PG8_SB(0, 1), b2 + hstep, voffB); PG8_STAGE(PG8_SA(0, 0), a2, voffA);
            PG8_WAIT_V(8); PG8_WAIT_L(0); PG8_BAR; PG8_MMA(1, 0, At, B0); PG8_MMA(1, 1, At, B1); PG8_BAR; PG8_SCHED;
            PG8_LDB(B0, 1, 0); PG8_LDB(B1, 1, 1); PG8_SCHED; PG8_LDA(At, 1, 0); PG8_STAGE(PG8_SA(0, 1), a2 + hstep, voffA);
            PG8_WAIT_V(8); PG8_WAIT_L(0); PG8_BAR; PG8_MMA(0, 0, At, B0); PG8_MMA(0, 1, At, B1); PG8_BAR; PG8_SCHED;
            PG8_LDA(At, 1, 1); PG8_STAGE(PG8_SB(1, 0), b3, voffB); PG8_STAGE(PG8_SB(1, 1), b3 + hstep, voffB); PG8_STAGE(PG8_SA(1, 0), a3, voffA);
            PG8_WAIT_V(8); PG8_WAIT_L(0); PG8_BAR; PG8_MMA(1, 0, At, B0); PG8_MMA(1, 1, At, B1); PG8_BAR; PG8_SCHED;
            } else {
            PG8_LDB(B0, 0, 0); PG8_SCHED; PG8_LDA(At, 0, 0); PG8_STAGE(PG8_SA(1, 1), a1 + hstep, voffA);
            PG8_WAIT_L(8); PG8_BAR; PG8_WAIT_L(0); PG8_MMA(0, 0, At, B0); PG8_BAR; PG8_SCHED;
            PG8_LDB(B1, 0, 1); PG8_STAGE(PG8_SB(0, 0), b2, voffB);
            PG8_BAR; PG8_WAIT_L(0); PG8_MMA(0, 1, At, B1); PG8_BAR;
            PG8_LDA(At, 0, 1); PG8_STAGE(PG8_SA(0, 0), a2, voffA);
            PG8_BAR; PG8_WAIT_L(0); PG8_MMA(1, 0, At, B0); PG8_BAR; PG8_SCHED;
            PG8_STAGE(PG8_SB(0, 1), b2 + hstep, voffB);
            PG8_WAIT_V(6); PG8_BAR; PG8_MMA(1, 1, At, B1); PG8_BAR;
            PG8_LDB(B0, 1, 0); PG8_SCHED; PG8_LDA(At, 1, 0); PG8_STAGE(PG8_SA(0, 1), a2 + hstep, voffA);
            PG8_WAIT_L(8); PG8_BAR; PG8_WAIT_L(0); PG8_MMA(0, 0, At, B0); PG8_BAR; PG8_SCHED;
            PG8_LDB(B1, 1, 1); PG8_STAGE(PG8_SB(1, 0), b3, voffB);
            PG8_BAR; PG8_WAIT_L(0); PG8_MMA(0, 1, At, B1); PG8_BAR;
            PG8_LDA(At, 1, 1); PG8_STAGE(PG8_SA(1, 0), a3, voffA);
            PG8_BAR; PG8_WAIT_L(0); PG8_MMA(1, 0, At, B0); PG8_BAR; PG8_SCHED;
            PG8_STAGE(PG8_SB(1, 1), b3 + hstep, voffB);
            PG8_WAIT_V(6); PG8_BAR; PG8_MMA(1, 1, At, B1); PG8_BAR;
            }
        }
        if constexpr (ALIGN_EPI) { if (wr == 0) PG8_BAR; }
        if constexpr (!Epi::AFTER_DRAIN) { E(acc, cur, wr, wc, fr, fq); S.done(cur); }
        if (!has_next) break;
#pragma unroll
        for (int a = 0; a < 2; ++a)
#pragma unroll
            for (int b = 0; b < 2; ++b)
#pragma unroll
                for (int m = 0; m < 4; ++m)
#pragma unroll
                    for (int n = 0; n < 2; ++n) acc[a][b][m][n] = (f32x4){0.f, 0.f, 0.f, 0.f};
        cur = nxt; cA = nA; cB = nB; ++ui;
        if constexpr (ALIGN_EPI) { if (wr == 1) PG8_BAR; }
    }
    PG8_WAIT_V(0);
    if constexpr (!ALIGN_EPI) { if (wr == 0) PG8_BAR; }
    PG8_BAR;
    if constexpr (Epi::AFTER_DRAIN) { E.fused(acc, cur, wr, wc, fr, fq, lds, wid, lane); S.done(cur); }
#undef PG8_SA
#undef PG8_SB
#undef PG8_STAGE
#undef PG8_LDA
#undef PG8_LDB
#undef PG8_MMA
#undef PG8_WAIT_V
#undef PG8_WAIT_L
#undef PG8_BAR
#undef PG8_SCHED
}
}
#define GAS __attribute__((address_space(1)))
#define LAS __attribute__((address_space(3)))
typedef unsigned short bf16;
typedef unsigned v4u __attribute__((ext_vector_type(4)));
typedef float f32x4 __attribute__((ext_vector_type(4)));
typedef short bf16x8 __attribute__((ext_vector_type(8)));
typedef GAS unsigned gu32;
typedef GAS unsigned long long gu64;
#define RLX_AGENT __ATOMIC_RELAXED, __HIP_MEMORY_SCOPE_AGENT
#define LDS_WAIT() asm volatile("s_waitcnt lgkmcnt(0)" ::: "memory")
#define VM_WAIT() asm volatile("s_waitcnt vmcnt(0)" ::: "memory")
__device__ __forceinline__ unsigned long long rt() { return __builtin_amdgcn_s_memrealtime(); }
__device__ __forceinline__ unsigned f2bf(float f) { unsigned u = __builtin_bit_cast(unsigned, f); return (u + 0x7fffu + ((u >> 16) & 1u)) >> 16; }
__device__ __forceinline__ unsigned pk2(float lo, float hi) { return f2bf(lo) | (f2bf(hi) << 16); }

#define XB_TMO      128
#define XB_XCNT(j)  (256  + 64 * (j))
#define XB_XSUB(j)  (1280 + 64 * (j))
#define XB_XGEN(j)  (2304 + 64 * (j))
#define XB_TOP      3328
#define XB_TOPGEN   3392
#define XCD_BAR_WORDS 3456
#define XB_SPIN_CAP (1u << 18)

__device__ __forceinline__ unsigned xb_ld(unsigned* p)              { return __hip_atomic_load(p, __ATOMIC_RELAXED, __HIP_MEMORY_SCOPE_AGENT); }
__device__ __forceinline__ unsigned xb_add(unsigned* p, unsigned v) { return __hip_atomic_fetch_add(p, v, __ATOMIC_RELAXED, __HIP_MEMORY_SCOPE_AGENT); }
__device__ __forceinline__ unsigned xb_xcc_id() { return (unsigned)__builtin_amdgcn_s_getreg((3 << 11) | 20) & 0xFu; }
#define XB_SPIN(cond, bar) do { unsigned _sp = 0; while (cond) { __builtin_amdgcn_s_sleep(1); \
    if ((++_sp & 255u) == 0u) { if (xb_ld(&(bar)[XB_TMO])) break; if (_sp > XB_SPIN_CAP) { atomicAdd(&(bar)[XB_TMO], 1u); break; } } } } while (0)

struct XcdBarrier {
    unsigned* bar; unsigned x;
    volatile LAS unsigned* st;
};

__device__ __forceinline__ XcdBarrier xcd_barrier_post(unsigned* bar, volatile LAS unsigned* st) {
    XcdBarrier b; b.bar = bar; b.x = xb_xcc_id(); b.st = st;
    if (threadIdx.x == 0) (void)xb_add(&bar[XB_XCNT(b.x)], 1u);
    return b;
}
__device__ __forceinline__ void xcd_barrier_complete(unsigned* bar, unsigned x, unsigned& nloc, unsigned& nx) {
    const unsigned G = gridDim.x * gridDim.y * gridDim.z;
    unsigned sum, cnt, mine, sp = 0u;
    for (;;) {
        sum = 0u; cnt = 0u; mine = 0u;
#pragma unroll
        for (unsigned j = 0; j < 16; ++j) { const unsigned c = xb_ld(&bar[XB_XCNT(j)]); sum += c; cnt += (c > 0u) ? 1u : 0u; mine = (j == x) ? c : mine; }
        if (sum == G) break;
        __builtin_amdgcn_s_sleep(1);
        if ((++sp & 255u) == 0u) { if (xb_ld(&bar[XB_TMO])) break; if (sp > XB_SPIN_CAP) { atomicAdd(&bar[XB_TMO], 1u); break; } }
    }
    nloc = mine > 0u ? mine : 1u; nx = cnt > 0u ? cnt : 1u;
}

__device__ __forceinline__ void xcd_barrier(const XcdBarrier& b) {
    asm volatile("s_waitcnt vmcnt(0)" ::: "memory");
    __syncthreads();
    if (threadIdx.x == 0) {
        unsigned* bar = b.bar;
        __builtin_amdgcn_s_waitcnt(0);
        unsigned nloc = b.st[0], nx = b.st[1];
        if (nloc == 0u) { xcd_barrier_complete(bar, b.x, nloc, nx); b.st[0] = nloc; b.st[1] = nx; }
        const unsigned old = xb_add(&bar[XB_XSUB(b.x)], 1u);
        const unsigned gen = old / nloc;
        if (old + 1u == (gen + 1u) * nloc) {
            __builtin_amdgcn_fence(__ATOMIC_RELEASE, "agent");
            asm volatile("s_waitcnt vmcnt(0)" ::: "memory");
            const unsigned og = xb_add(&bar[XB_TOP], 1u);
            const unsigned tg = og / nx;
            if (og + 1u == (tg + 1u) * nx) xb_add(&bar[XB_TOPGEN], 1u);
            else XB_SPIN(xb_ld(&bar[XB_TOPGEN]) == tg, bar);
            __builtin_amdgcn_fence(__ATOMIC_ACQUIRE, "agent");
            xb_add(&bar[XB_XGEN(b.x)], 1u);
            asm volatile("s_waitcnt vmcnt(0)" ::: "memory");
        } else {
            XB_SPIN(xb_ld(&bar[XB_XGEN(b.x)]) == gen, bar);
            __builtin_amdgcn_fence(__ATOMIC_ACQUIRE, "agent");
            asm volatile("s_waitcnt vmcnt(0)" ::: "memory");
        }
    }
    __syncthreads();
}

namespace sbp {
using bf16x8 = __attribute__((ext_vector_type(8))) short;
using s16x4 = __attribute__((ext_vector_type(4))) short;
using f32x16 = __attribute__((ext_vector_type(16))) float;
using u32x4 = __attribute__((ext_vector_type(4))) unsigned;
typedef short v4i16_t __attribute__((ext_vector_type(4)));
typedef __attribute__((address_space(3))) const char* lds_cptr;
constexpr int PITCH = 512, OPITCH = 1024;
constexpr int NSLOT = 3, SLOTB = 8192;
constexpr int LDS_K = 0, LDS_V = NSLOT * SLOTB, LDS_OST = 2 * NSLOT * SLOTB, LDS_BYTES = LDS_OST + 8 * 4096;
__device__ __forceinline__ int crow(int r, int hi) { return (r & 3) + 8 * (r >> 2) + 4 * hi; }
__device__ __forceinline__ void glds16(const void* gsrc, unsigned lds_dst) { unsigned keep;
    asm volatile("s_mov_b32 %0, m0\n\ts_mov_b32 m0, %2\n\ts_nop 0\n\tglobal_load_lds_dwordx4 %1, off\n\ts_mov_b32 m0, %0" : "=&s"(keep) : "v"(gsrc), "s"(lds_dst) : "memory"); }
typedef float f32x2_t __attribute__((ext_vector_type(2))); typedef __bf16 bf16x2_t __attribute__((ext_vector_type(2)));
__device__ __forceinline__ unsigned cvtpk(float lo, float hi) { f32x2_t v = {lo, hi}; bf16x2_t b = __builtin_convertvector(v, bf16x2_t); return __builtin_bit_cast(unsigned, b); }
#define SBP_WAIT_BAR(N) asm volatile("s_waitcnt vmcnt(" #N ") lgkmcnt(0)\n\ts_barrier" ::: "memory")

__device__ __forceinline__ void qkt(f32x16& p0, f32x16& p1, lds_cptr Kslot, const bf16x8* qr, const f32x16& cinit, int r32, int hi) {
    lds_cptr kb = Kslot + hi * 1024 + r32 * 16;
#pragma unroll
    for (int d0 = 0; d0 < 4; ++d0) {
        const bf16x8 b0 = *(const __attribute__((address_space(3))) bf16x8*)(kb + d0 * 2048);
        const bf16x8 b1 = *(const __attribute__((address_space(3))) bf16x8*)(kb + d0 * 2048 + 512);
        if (d0 == 0) { p0 = __builtin_amdgcn_mfma_f32_32x32x16_bf16(b0, qr[0], cinit, 0, 0, 0); p1 = __builtin_amdgcn_mfma_f32_32x32x16_bf16(b1, qr[0], cinit, 0, 0, 0); }
        else { p0 = __builtin_amdgcn_mfma_f32_32x32x16_bf16(b0, qr[d0], p0, 0, 0, 0); p1 = __builtin_amdgcn_mfma_f32_32x32x16_bf16(b1, qr[d0], p1, 0, 0, 0); } }
}
__device__ __forceinline__ void pv(f32x16* o, int vb, bf16x8 pa0, bf16x8 pa1, bf16x8 pa2, bf16x8 pa3) {
#pragma unroll
    for (int d0 = 0; d0 < 2; ++d0) { s16x4 lo[4], hi[4];
#pragma unroll
        for (int ks = 0; ks < 4; ++ks) {
            asm volatile("ds_read_b64_tr_b16 %0,%1 offset:%c2" : "=&v"(lo[ks]) : "v"(vb), "i"(d0 * 4096 + ks * 1024) : "memory");
            asm volatile("ds_read_b64_tr_b16 %0,%1 offset:%c2" : "=&v"(hi[ks]) : "v"(vb), "i"(d0 * 4096 + ks * 1024 + 512) : "memory"); }
        asm volatile("s_waitcnt lgkmcnt(0)" ::: "memory"); __builtin_amdgcn_sched_barrier(0);
#define SBP_PK(k) (bf16x8){lo[k][0], lo[k][1], lo[k][2], lo[k][3], hi[k][0], hi[k][1], hi[k][2], hi[k][3]}
        o[d0] = __builtin_amdgcn_mfma_f32_32x32x16_bf16(pa0, SBP_PK(0), o[d0], 0, 0, 0);
        o[d0] = __builtin_amdgcn_mfma_f32_32x32x16_bf16(pa1, SBP_PK(1), o[d0], 0, 0, 0);
        o[d0] = __builtin_amdgcn_mfma_f32_32x32x16_bf16(pa2, SBP_PK(2), o[d0], 0, 0, 0);
        o[d0] = __builtin_amdgcn_mfma_f32_32x32x16_bf16(pa3, SBP_PK(3), o[d0], 0, 0, 0);
#undef SBP_PK
    }
}
template <bool MASKED>
__device__ __forceinline__ void sb_tile(const f32x16& p0, const f32x16& p1, float& carry, float f0, int hi, int kbase, int qrel, u32x4& pw0, u32x4& pw1, u32x4& pw2, u32x4& pw3) {
    float z[32], l[32], a[32];
#pragma unroll
    for (int r = 0; r < 16; ++r) { z[r] = p0[r]; z[16 + r] = p1[r]; }
#pragma unroll
    for (int e = 0; e < 32; ++e) {
        const float ex = __builtin_amdgcn_exp2f(fminf(z[e], 60.f));
        l[e] = -__builtin_amdgcn_logf(1.0f + ex);
        if (MASKED) { const int key = kbase + 8 * (e >> 2) + 4 * hi + (e & 3); if (key >= qrel) l[e] = 0.f; }
    }
    float G[8], PS[8];
#pragma unroll
    for (int k = 0; k < 8; ++k) { G[k] = (l[4 * k] + l[4 * k + 1]) + (l[4 * k + 2] + l[4 * k + 3]);
        const auto rr = __builtin_amdgcn_permlane32_swap(__float_as_uint(G[k]), __float_as_uint(G[k]), false, false);
        PS[k] = __uint_as_float(rr[0]) + __uint_as_float(rr[1]); }
    float suf = carry;
#pragma unroll
    for (int k = 7; k >= 0; --k) {
        float run = suf + f0 * (PS[k] - G[k]);
#pragma unroll
        for (int j = 3; j >= 0; --j) { const int e = 4 * k + j;
            float v = __builtin_amdgcn_exp2f((z[e] + l[e]) + run);
            if (MASKED) { const int key = kbase + 8 * k + 4 * hi + j; if (key >= qrel) v = 0.f; }
            a[e] = v; run += l[e]; }
        suf += PS[k];
    }
    carry = suf;
    pw0 = (u32x4){cvtpk(a[0], a[1]), cvtpk(a[2], a[3]), cvtpk(a[4], a[5]), cvtpk(a[6], a[7])};
    pw1 = (u32x4){cvtpk(a[8], a[9]), cvtpk(a[10], a[11]), cvtpk(a[12], a[13]), cvtpk(a[14], a[15])};
    pw2 = (u32x4){cvtpk(a[16], a[17]), cvtpk(a[18], a[19]), cvtpk(a[20], a[21]), cvtpk(a[22], a[23])};
    pw3 = (u32x4){cvtpk(a[24], a[25]), cvtpk(a[26], a[27]), cvtpk(a[28], a[29]), cvtpk(a[30], a[31])};
}

__device__ __forceinline__ void unit(int b, int h, int qb, const unsigned short* Q, const unsigned short* K, const unsigned short* V, unsigned short* O, float bias2, __attribute__((address_space(3))) unsigned char* shm3u) {
    const int tid = threadIdx.x, lane = tid & 63, r32 = lane & 31, hi = lane >> 5; const int wid = __builtin_amdgcn_readfirstlane(tid >> 6);
    const long rowbase = (long)b * 2048; const int q0 = qb * 256;
    const unsigned short* Qw = Q + (rowbase + q0 + wid * 32) * PITCH + h * 64;
    const unsigned short* Kh = K + rowbase * PITCH + h * 64; const unsigned short* Vh = V + rowbase * PITCH + h * 64;
    const lds_cptr shm3 = (lds_cptr)shm3u;
    const unsigned lds0 = (unsigned)(uintptr_t)shm3u;
    const unsigned short* ksrc = Kh + (long)lane * PITCH + wid * 8;
    const unsigned short* vsrc = Vh + (long)(16 * (wid & 3) + (lane >> 2)) * PITCH + (wid >> 2) * 32 + (lane & 3) * 8;
    const unsigned kdst = lds0 + LDS_K + wid * 1024, vdst = lds0 + LDS_V + wid * 1024;
#define SBP_DMA_K(t, slot) glds16(ksrc + (long)(t) * 64 * PITCH, (unsigned)__builtin_amdgcn_readfirstlane(kdst + (slot)))
#define SBP_DMA_V(t, slot) glds16(vsrc + (long)(t) * 64 * PITCH, (unsigned)__builtin_amdgcn_readfirstlane(vdst + (slot)))
    const int vb0 = (int)(lds0 + LDS_V) + ((lane >> 4) & 1) * 32 + (lane & 3) * 8 + (4 * hi + ((lane & 15) >> 2)) * 64;
    const int NT = 4 * qb + 4;
    bf16x8 qr[4];
#pragma unroll
    for (int d0 = 0; d0 < 4; ++d0) qr[d0] = *reinterpret_cast<const bf16x8*>(&Qw[(long)r32 * PITCH + d0 * 16 + hi * 8]);
    SBP_DMA_K(NT - 1, 0); SBP_DMA_V(NT - 1, 0);
    SBP_DMA_K(NT - 2, SLOTB); SBP_DMA_V(NT - 2, SLOTB);
    f32x16 o[2]; o[0] = f32x16{}; o[1] = f32x16{};
    f32x16 cinit;
#pragma unroll
    for (int r = 0; r < 16; ++r) cinit[r] = bias2;
    const float f0 = hi == 0 ? 1.f : 0.f;
    const int qrel = wid * 32 + r32;
    float carry = 0.f;
    int sl_cur = 0, sl_nn = 2 * SLOTB;
    for (int i = 0; i < NT; ++i) {
        if (i + 1 < NT) { SBP_WAIT_BAR(2); } else { SBP_WAIT_BAR(0); }
        if (i + 2 < NT) { SBP_DMA_K(NT - 3 - i, sl_nn); SBP_DMA_V(NT - 3 - i, sl_nn); }
        const int jb = 3 - i;
        const bool skip = (i < 4) && (64 * jb >= wid * 32 + 31);
        if (!skip) {
            f32x16 p0, p1; u32x4 pw0, pw1, pw2, pw3;
            qkt(p0, p1, shm3 + LDS_K + sl_cur, qr, cinit, r32, hi);
            if (i < 4) sb_tile<true>(p0, p1, carry, f0, hi, 64 * jb, qrel, pw0, pw1, pw2, pw3);
            else sb_tile<false>(p0, p1, carry, f0, hi, 0, 0, pw0, pw1, pw2, pw3);
            pv(o, vb0 + sl_cur, __builtin_bit_cast(bf16x8, pw0), __builtin_bit_cast(bf16x8, pw1), __builtin_bit_cast(bf16x8, pw2), __builtin_bit_cast(bf16x8, pw3));
        }
        sl_cur = (sl_cur == 2 * SLOTB) ? 0 : sl_cur + SLOTB; sl_nn = (sl_nn == 2 * SLOTB) ? 0 : sl_nn + SLOTB;
    }
    unsigned short* Ow = O + (rowbase + q0 + wid * 32) * OPITCH + h * 64;
    { __attribute__((address_space(3))) unsigned short* stg = (__attribute__((address_space(3))) unsigned short*)(shm3u + LDS_OST) + wid * 2048;
#pragma unroll
        for (int r = 0; r < 16; ++r) { const int orow = crow(r, hi);
#pragma unroll
            for (int d0 = 0; d0 < 2; ++d0) stg[orow * 64 + d0 * 32 + r32] = (unsigned short)f2bf(o[d0][r]); }
        asm volatile("s_waitcnt lgkmcnt(0)" ::: "memory");
#pragma unroll
        for (int i = 0; i < 4; ++i) { const int row = i * 8 + (lane >> 3), ch = lane & 7; const u32x4 v = *(const __attribute__((address_space(3))) u32x4*)(stg + row * 64 + ch * 8); *(u32x4*)(Ow + (long)row * OPITCH + ch * 8) = v; } }
    asm volatile("s_waitcnt lgkmcnt(0)\n\ts_barrier" ::: "memory");
#undef SBP_DMA_K
#undef SBP_DMA_V
}
#undef SBP_WAIT_BAR
}

namespace retp {
using bf16x8 = __attribute__((ext_vector_type(8))) short;
using f32x16 = __attribute__((ext_vector_type(16))) float;
using u32x4 = __attribute__((ext_vector_type(4))) unsigned;
using u32x2 = __attribute__((ext_vector_type(2))) unsigned;
#define RLAS __attribute__((address_space(3)))
constexpr int CH = 64, NCH = 2048 / CH;
constexpr int PQ = 272, PT = 144;
constexpr int L_QS = 0, L_KS = L_QS + 64 * PQ, L_VT = L_KS + 64 * PQ, L_KDT = L_VT + 128 * PT, L_PS = L_KDT + 128 * PT, L_ST = L_PS + 64 * PT, L_END = L_ST + 128 * PQ;
static_assert(L_END <= 131072, "retention LDS");
__device__ __forceinline__ int crow(int r, int hi) { return (r & 3) + 8 * (r >> 2) + 4 * hi; }
__device__ __forceinline__ bf16x8 frag(RLAS const unsigned char* base, int row, int pitch, int kbyte, int hi) { return *(RLAS const bf16x8*)(base + row * pitch + kbyte + 16 * hi); }

__device__ __forceinline__ void unit(int b, int h, const unsigned short* QR, const unsigned short* KR, const unsigned short* VR, float* OR, float* Sout, RLAS unsigned char* lds) {
    const int tid = threadIdx.x, lane = tid & 63, r32 = lane & 31, hi = lane >> 5; const int w = __builtin_amdgcn_readfirstlane(tid >> 6);
    const float lg2 = log2f(1.0f - exp2f(-5.0f - (float)h));
    const long rowbase = (long)b * 2048;
    for (int i = tid; i < (L_END - L_PS) / 16; i += 512) *(RLAS u32x4*)(lds + L_PS + 16 * i) = (u32x4){0u, 0u, 0u, 0u};
    f32x16 S0 = f32x16{}, S1 = f32x16{};
    const int eb = w >> 1, db0 = 2 * (w & 1);
    const unsigned short* gq = QR + (rowbase + lane) * 512 + h * 128 + 16 * w;
    const unsigned short* gk = KR + (rowbase + lane) * 512 + h * 128 + 16 * w;
    const unsigned short* gv = VR + (rowbase + lane) * 512 + h * 128 + 16 * w;
    u32x4 q0 = *(const u32x4*)gq, q1 = *(const u32x4*)(gq + 8), k0 = *(const u32x4*)gk, k1 = *(const u32x4*)(gk + 8), v0 = *(const u32x4*)gv, v1 = *(const u32x4*)(gv + 8);
    const float kdec = exp2f(lg2 * (float)(63 - lane));
    const float g64 = exp2f(lg2 * 64.0f);
    __syncthreads();
    for (int c = 0; c < NCH; ++c) {
        *(RLAS u32x4*)(lds + L_QS + lane * PQ + 32 * w) = q0; *(RLAS u32x4*)(lds + L_QS + lane * PQ + 32 * w + 16) = q1;
        *(RLAS u32x4*)(lds + L_KS + lane * PQ + 32 * w) = k0; *(RLAS u32x4*)(lds + L_KS + lane * PQ + 32 * w + 16) = k1;
#pragma unroll
        for (int q = 0; q < 8; ++q) {
            const unsigned kv = q < 4 ? k0[q] : k1[q - 4], vv = q < 4 ? v0[q] : v1[q - 4];
            const float ka = __uint_as_float(kv << 16) * kdec, kb = __uint_as_float(kv & 0xffff0000u) * kdec;
            *(RLAS unsigned short*)(lds + L_KDT + (16 * w + 2 * q) * PT + 2 * lane) = (unsigned short)f2bf(ka);
            *(RLAS unsigned short*)(lds + L_KDT + (16 * w + 2 * q + 1) * PT + 2 * lane) = (unsigned short)f2bf(kb);
            *(RLAS unsigned short*)(lds + L_VT + (16 * w + 2 * q) * PT + 2 * lane) = (unsigned short)(vv & 0xffffu);
            *(RLAS unsigned short*)(lds + L_VT + (16 * w + 2 * q + 1) * PT + 2 * lane) = (unsigned short)(vv >> 16);
        }
        if (c > 0) {
#pragma unroll
            for (int r = 0; r < 16; ++r) { const int e = 32 * eb + crow(r, hi);
                *(RLAS unsigned short*)(lds + L_ST + e * PQ + (32 * db0 + r32) * 2) = (unsigned short)f2bf(S0[r]);
                *(RLAS unsigned short*)(lds + L_ST + e * PQ + (32 * (db0 + 1) + r32) * 2) = (unsigned short)f2bf(S1[r]); }
        }
        __syncthreads();
        if (c + 1 < NCH) { const long o = (long)(c + 1) * CH * 512;
            q0 = *(const u32x4*)(gq + o); q1 = *(const u32x4*)(gq + o + 8); k0 = *(const u32x4*)(gk + o); k1 = *(const u32x4*)(gk + o + 8); v0 = *(const u32x4*)(gv + o); v1 = *(const u32x4*)(gv + o + 8); }
        if (w < 3) {
            const int jb = w >> 1, ib = (w + 1) >> 1;
            f32x16 s = f32x16{};
#pragma unroll
            for (int ks = 0; ks < 8; ++ks) s = __builtin_amdgcn_mfma_f32_32x32x16_bf16(frag(lds + L_KS, 32 * jb + r32, PQ, 32 * ks, hi), frag(lds + L_QS, 32 * ib + r32, PQ, 32 * ks, hi), s, 0, 0, 0);
            const int i = 32 * ib + r32;
#pragma unroll
            for (int g = 0; g < 4; ++g) { float pvv[4];
#pragma unroll
                for (int jj = 0; jj < 4; ++jj) { const int j = 32 * jb + 8 * g + 4 * hi + jj; pvv[jj] = (i >= j) ? s[4 * g + jj] * exp2f(lg2 * (float)(i - j)) : 0.f; }
                *(RLAS u32x2*)(lds + L_PS + i * PT + (32 * jb + 8 * g + 4 * hi) * 2) = (u32x2){pk2(pvv[0], pvv[1]), pk2(pvv[2], pvv[3])}; }
        }
        __syncthreads();
        { const int ib = w >> 2, eo = w & 3;
            f32x16 oi = f32x16{}, oc = f32x16{};
#pragma unroll
            for (int ks = 0; ks < 4; ++ks) oi = __builtin_amdgcn_mfma_f32_32x32x16_bf16(frag(lds + L_PS, 32 * ib + r32, PT, 32 * ks, hi), frag(lds + L_VT, 32 * eo + r32, PT, 32 * ks, hi), oi, 0, 0, 0);
#pragma unroll
            for (int ks = 0; ks < 8; ++ks) oc = __builtin_amdgcn_mfma_f32_32x32x16_bf16(frag(lds + L_QS, 32 * ib + r32, PQ, 32 * ks, hi), frag(lds + L_ST, 32 * eo + r32, PQ, 32 * ks, hi), oc, 0, 0, 0);
            float* op = OR + (rowbase + (long)c * CH) * 512 + h * 128 + 32 * eo + r32;
#pragma unroll
            for (int r = 0; r < 16; ++r) { const int i = 32 * ib + crow(r, hi); op[(long)i * 512] = oi[r] + exp2f(lg2 * (float)(i + 1)) * oc[r]; }
        }
#pragma unroll
        for (int r = 0; r < 16; ++r) { S0[r] *= g64; S1[r] *= g64; }
#pragma unroll
        for (int ks = 0; ks < 4; ++ks) { const bf16x8 a = frag(lds + L_VT, 32 * eb + r32, PT, 32 * ks, hi);
            S0 = __builtin_amdgcn_mfma_f32_32x32x16_bf16(a, frag(lds + L_KDT, 32 * db0 + r32, PT, 32 * ks, hi), S0, 0, 0, 0);
            S1 = __builtin_amdgcn_mfma_f32_32x32x16_bf16(a, frag(lds + L_KDT, 32 * (db0 + 1) + r32, PT, 32 * ks, hi), S1, 0, 0, 0); }
        __syncthreads();
    }
#pragma unroll
    for (int r = 0; r < 16; ++r) { const int e = 32 * eb + crow(r, hi);
        Sout[(long)(32 * db0 + r32) * 128 + e] = S0[r]; Sout[(long)(32 * (db0 + 1) + r32) * 128 + e] = S1[r]; }
}
#undef RLAS
}

namespace crs {
using bf16x8 = __attribute__((ext_vector_type(8))) short;
using s16x4 = __attribute__((ext_vector_type(4))) short;
using f32x16 = __attribute__((ext_vector_type(16))) float;
using u32x4 = __attribute__((ext_vector_type(4))) unsigned;
typedef __attribute__((address_space(3))) const char* lds_cptr;
constexpr int PITCH = 1024, SLOT = 32768, L_KA = 0, L_KB = SLOT, L_VA = 2 * SLOT, L_VB = 3 * SLOT;
__device__ __forceinline__ int crow(int r, int hi) { return (r & 3) + 8 * (r >> 2) + 4 * hi; }
#define CRS_WAIT_BAR(N) asm volatile("s_waitcnt vmcnt(" #N ") lgkmcnt(0)\n\ts_barrier" ::: "memory")

__device__ __forceinline__ void scores(f32x16& pa, f32x16& pb, lds_cptr slot, const bf16x8* qr, int r32, int hi) {
    lds_cptr kb = slot + hi * 1024 + r32 * 16;
    pa = f32x16{}; pb = f32x16{};
#pragma unroll
    for (int ks = 0; ks < 16; ++ks) {
        const bf16x8 b0 = *(const __attribute__((address_space(3))) bf16x8*)(kb + ks * 2048);
        const bf16x8 b1 = *(const __attribute__((address_space(3))) bf16x8*)(kb + ks * 2048 + 512);
        pa = __builtin_amdgcn_mfma_f32_32x32x16_bf16(b0, qr[ks], pa, 0, 0, 0);
        pb = __builtin_amdgcn_mfma_f32_32x32x16_bf16(b1, qr[ks], pb, 0, 0, 0); }
}
template <int DH>
__device__ __forceinline__ void pv4(f32x16* o, int vb, bf16x8 pa0, bf16x8 pa1, bf16x8 pa2, bf16x8 pa3) {
#pragma unroll
    for (int d0 = 0; d0 < 4; ++d0) { s16x4 lo[4], hi[4];
#pragma unroll
        for (int ks = 0; ks < 4; ++ks) {
            asm volatile("ds_read_b64_tr_b16 %0,%1 offset:%c2" : "=&v"(lo[ks]) : "v"(vb), "i"((DH * 4 + d0) * 4096 + ks * 1024) : "memory");
            asm volatile("ds_read_b64_tr_b16 %0,%1 offset:%c2" : "=&v"(hi[ks]) : "v"(vb), "i"((DH * 4 + d0) * 4096 + ks * 1024 + 512) : "memory"); }
        asm volatile("s_waitcnt lgkmcnt(0)" ::: "memory"); __builtin_amdgcn_sched_barrier(0);
#define CRS_PK(k) (bf16x8){lo[k][0], lo[k][1], lo[k][2], lo[k][3], hi[k][0], hi[k][1], hi[k][2], hi[k][3]}
        o[d0] = __builtin_amdgcn_mfma_f32_32x32x16_bf16(pa0, CRS_PK(0), o[d0], 0, 0, 0);
        o[d0] = __builtin_amdgcn_mfma_f32_32x32x16_bf16(pa1, CRS_PK(1), o[d0], 0, 0, 0);
        o[d0] = __builtin_amdgcn_mfma_f32_32x32x16_bf16(pa2, CRS_PK(2), o[d0], 0, 0, 0);
        o[d0] = __builtin_amdgcn_mfma_f32_32x32x16_bf16(pa3, CRS_PK(3), o[d0], 0, 0, 0);
#undef CRS_PK
    }
}
__device__ __forceinline__ float hmax16(const f32x16& v) { float a = fmaxf(fmaxf(v[0], v[1]), fmaxf(v[2], v[3])), b = fmaxf(fmaxf(v[4], v[5]), fmaxf(v[6], v[7])), c = fmaxf(fmaxf(v[8], v[9]), fmaxf(v[10], v[11])), d = fmaxf(fmaxf(v[12], v[13]), fmaxf(v[14], v[15])); return fmaxf(fmaxf(a, b), fmaxf(c, d)); }
__device__ __forceinline__ float expsum16(f32x16& v, float m) { float s = 0.f;
#pragma unroll
    for (int r = 0; r < 16; ++r) { v[r] = __builtin_amdgcn_exp2f(v[r] - m); s += v[r]; } return s; }
__device__ __forceinline__ unsigned cvtpk(float lo, float hi) { typedef float f2 __attribute__((ext_vector_type(2))); typedef __bf16 b2 __attribute__((ext_vector_type(2))); f2 v = {lo, hi}; b2 b = __builtin_convertvector(v, b2); return __builtin_bit_cast(unsigned, b); }
__device__ __forceinline__ void pack16(const f32x16& v, float s, u32x4& lo, u32x4& hi) {
    lo = (u32x4){cvtpk(v[0] * s, v[1] * s), cvtpk(v[2] * s, v[3] * s), cvtpk(v[4] * s, v[5] * s), cvtpk(v[6] * s, v[7] * s)};
    hi = (u32x4){cvtpk(v[8] * s, v[9] * s), cvtpk(v[10] * s, v[11] * s), cvtpk(v[12] * s, v[13] * s), cvtpk(v[14] * s, v[15] * s)}; }

__device__ __forceinline__ void unit(const unsigned short* Qt, const unsigned short* Kh, const unsigned short* Vh, unsigned short* Ot, __attribute__((address_space(3))) unsigned char* shm3u) {
    const int tid = threadIdx.x, lane = tid & 63, r32 = lane & 31, hi = lane >> 5; const int wid = __builtin_amdgcn_readfirstlane(tid >> 6);
    const lds_cptr shm3 = (lds_cptr)shm3u; const unsigned lds0 = (unsigned)(uintptr_t)shm3u;
    const unsigned kvoff = (unsigned)(lane * PITCH * 2 + wid * 16);
    const unsigned vvoff = (unsigned)((16 * (wid & 3) + (lane >> 2)) * PITCH * 2 + (wid >> 2) * 64 + (lane & 3) * 16);
#define CRS_GLDS(sbase, voff, imm, ldsdst) do { unsigned keep_; asm volatile("s_mov_b32 %0, m0\n\ts_mov_b32 m0, %3\n\ts_nop 0\n\tglobal_load_lds_dwordx4 %1, %2 offset:%c4\n\ts_mov_b32 m0, %0" : "=&s"(keep_) : "v"(voff), "s"(sbase), "s"(ldsdst), "i"(imm) : "memory"); } while (0)
#define CRS_DMA_K(t, slot) do { const unsigned short* sb_ = Kh + (long)(t) * 64 * PITCH; _Pragma("unroll") for (int i_ = 0; i_ < 4; ++i_) CRS_GLDS(sb_, kvoff, i_ * 128, (unsigned)__builtin_amdgcn_readfirstlane(lds0 + (slot) + (wid + 8 * i_) * 1024 - i_ * 128)); } while (0)
#define CRS_DMA_V(t, slot) do { const unsigned short* sb_ = Vh + (long)(t) * 64 * PITCH; _Pragma("unroll") for (int i_ = 0; i_ < 4; ++i_) CRS_GLDS(sb_, vvoff, i_ * 128, (unsigned)__builtin_amdgcn_readfirstlane(lds0 + (slot) + (wid + 8 * i_) * 1024 - i_ * 128)); } while (0)
    bf16x8 qr[16];
    const unsigned short* Qw = Qt + (long)(wid * 32 + r32) * PITCH + hi * 8;
#pragma unroll
    for (int ks = 0; ks < 16; ++ks) qr[ks] = *reinterpret_cast<const bf16x8*>(Qw + ks * 16);
    CRS_DMA_K(0, L_KA); CRS_DMA_K(1, L_KB); CRS_DMA_V(0, L_VA); CRS_DMA_V(1, L_VB);
    f32x16 p0, p1, p2, p3, p4, p5, p6, p7;
    CRS_WAIT_BAR(12); scores(p0, p1, shm3 + L_KA, qr, r32, hi);
    CRS_WAIT_BAR(8); CRS_DMA_K(2, L_KA); scores(p2, p3, shm3 + L_KB, qr, r32, hi);
    CRS_WAIT_BAR(0); CRS_DMA_K(3, L_KB); scores(p4, p5, shm3 + L_KA, qr, r32, hi);
    CRS_WAIT_BAR(0); CRS_DMA_V(2, L_KA); scores(p6, p7, shm3 + L_KB, qr, r32, hi);
    float m = fmaxf(fmaxf(fmaxf(hmax16(p0), hmax16(p1)), fmaxf(hmax16(p2), hmax16(p3))), fmaxf(fmaxf(hmax16(p4), hmax16(p5)), fmaxf(hmax16(p6), hmax16(p7))));
    { const auto rr = __builtin_amdgcn_permlane32_swap(__float_as_uint(m), __float_as_uint(m), false, false); m = fmaxf(__uint_as_float(rr[0]), __uint_as_float(rr[1])); }
    float s = ((expsum16(p0, m) + expsum16(p1, m)) + (expsum16(p2, m) + expsum16(p3, m))) + ((expsum16(p4, m) + expsum16(p5, m)) + (expsum16(p6, m) + expsum16(p7, m)));
    { const auto rr = __builtin_amdgcn_permlane32_swap(__float_as_uint(s), __float_as_uint(s), false, false); s = __uint_as_float(rr[0]) + __uint_as_float(rr[1]); }
    const float inv = 1.0f / s;
    u32x4 w0, w1, w2, w3, w4, w5, w6, w7, w8, w9, w10, w11, w12, w13, w14, w15;
    pack16(p0, inv, w0, w1); pack16(p1, inv, w2, w3); pack16(p2, inv, w4, w5); pack16(p3, inv, w6, w7);
    pack16(p4, inv, w8, w9); pack16(p5, inv, w10, w11); pack16(p6, inv, w12, w13); pack16(p7, inv, w14, w15);
    CRS_WAIT_BAR(4);
    CRS_DMA_V(3, L_KB);
    const int vboff = ((lane >> 4) & 1) * 32 + (lane & 3) * 8 + (4 * hi + ((lane & 15) >> 2)) * 64;
#define CRS_BF(x) __builtin_bit_cast(bf16x8, x)
    unsigned opk[4][8];
    { f32x16 o[4];
#pragma unroll
      for (int d0 = 0; d0 < 4; ++d0) o[d0] = f32x16{};
      pv4<0>(o, (int)lds0 + L_VA + vboff, CRS_BF(w0), CRS_BF(w1), CRS_BF(w2), CRS_BF(w3));
      pv4<0>(o, (int)lds0 + L_VB + vboff, CRS_BF(w4), CRS_BF(w5), CRS_BF(w6), CRS_BF(w7));
      CRS_WAIT_BAR(4);
      pv4<0>(o, (int)lds0 + L_KA + vboff, CRS_BF(w8), CRS_BF(w9), CRS_BF(w10), CRS_BF(w11));
      CRS_WAIT_BAR(0);
      pv4<0>(o, (int)lds0 + L_KB + vboff, CRS_BF(w12), CRS_BF(w13), CRS_BF(w14), CRS_BF(w15));
#pragma unroll
      for (int d0 = 0; d0 < 4; ++d0)
#pragma unroll
          for (int k = 0; k < 8; ++k) opk[d0][k] = cvtpk(o[d0][2 * k], o[d0][2 * k + 1]); }
    f32x16 o[4];
#pragma unroll
    for (int d0 = 0; d0 < 4; ++d0) o[d0] = f32x16{};
    pv4<1>(o, (int)lds0 + L_VA + vboff, CRS_BF(w0), CRS_BF(w1), CRS_BF(w2), CRS_BF(w3));
    pv4<1>(o, (int)lds0 + L_VB + vboff, CRS_BF(w4), CRS_BF(w5), CRS_BF(w6), CRS_BF(w7));
    pv4<1>(o, (int)lds0 + L_KA + vboff, CRS_BF(w8), CRS_BF(w9), CRS_BF(w10), CRS_BF(w11));
    pv4<1>(o, (int)lds0 + L_KB + vboff, CRS_BF(w12), CRS_BF(w13), CRS_BF(w14), CRS_BF(w15));
#undef CRS_BF
    CRS_WAIT_BAR(0);
    { __attribute__((address_space(3))) unsigned short* stg = (__attribute__((address_space(3))) unsigned short*)(shm3u + wid * 16384);
      __attribute__((address_space(3))) unsigned short* stl = stg + hi * 1024 + r32;
#pragma unroll
        for (int d0 = 0; d0 < 4; ++d0)
#pragma unroll
            for (int k = 0; k < 8; ++k) { stl[crow(2 * k, 0) * 256 + d0 * 32] = (unsigned short)(opk[d0][k] & 0xffffu); stl[crow(2 * k + 1, 0) * 256 + d0 * 32] = (unsigned short)(opk[d0][k] >> 16); }
#pragma unroll
        for (int d0 = 0; d0 < 4; ++d0)
#pragma unroll
            for (int r = 0; r < 16; ++r) stl[crow(r, 0) * 256 + (4 + d0) * 32] = (unsigned short)f2bf(o[d0][r]);
        asm volatile("s_waitcnt lgkmcnt(0)" ::: "memory");
        unsigned short* Ow = Ot + (long)(wid * 32) * PITCH;
        int lane2 = lane; asm volatile("" : "+v"(lane2));
        const int lofs = (lane2 >> 5) * 256 + (lane2 & 31) * 8; const long gofs = (long)(lane2 >> 5) * PITCH + (lane2 & 31) * 8;
#pragma unroll
        for (int i = 0; i < 16; ++i) { const u32x4 v = *(const __attribute__((address_space(3))) u32x4*)(stg + lofs + i * 512); *(u32x4*)(Ow + gofs + (long)i * 2 * PITCH) = v; } }
    asm volatile("s_waitcnt lgkmcnt(0)\n\ts_barrier" ::: "memory");
#undef CRS_DMA_K
#undef CRS_DMA_V
#undef CRS_GLDS
}
#undef CRS_WAIT_BAR
}

namespace scr {
#define SLAS __attribute__((address_space(3)))
typedef float f4 __attribute__((ext_vector_type(4)));
__device__ __forceinline__ float wave_sum(float v) {
#pragma unroll
    for (int o = 1; o < 64; o <<= 1) v += __shfl_xor(v, o);
    return v; }
__device__ __forceinline__ float wave_max(float v) {
#pragma unroll
    for (int o = 1; o < 64; o <<= 1) v = fmaxf(v, __shfl_xor(v, o));
    return v; }
constexpr int L_SC = 0, L_RED = 4096, L_END = L_RED + 8 * 64 * 16 * 4;
__device__ __forceinline__ float xreduce4(float p0, float p1, float p2, float p3, int lane) {
    const bool b5 = (lane & 32) != 0, b4 = (lane & 16) != 0;
    const float s0 = b5 ? p0 : p2, s1 = b5 ? p1 : p3, k0 = b5 ? p2 : p0, k1 = b5 ? p3 : p1;
    const float r0 = k0 + __shfl_xor(s0, 32), r1 = k1 + __shfl_xor(s1, 32);
    float s = (b4 ? r1 : r0) + __shfl_xor(b4 ? r0 : r1, 16);
    s += __shfl_xor(s, 8); s += __shfl_xor(s, 4); s += __shfl_xor(s, 2); s += __shfl_xor(s, 1);
    return s;
}
__device__ __forceinline__ f4 bf4(unsigned long long v) { const unsigned lo = (unsigned)v, hi = (unsigned)(v >> 32); return (f4){__uint_as_float(lo << 16), __uint_as_float(lo & 0xffff0000u), __uint_as_float(hi << 16), __uint_as_float(hi & 0xffff0000u)}; }
__device__ __forceinline__ float dot4(f4 a, f4 b) { return (a.x * b.x + a.y * b.y) + (a.z * b.z + a.w * b.w); }

__device__ __forceinline__ void item(int b, int h, long row0, const unsigned short* QX, const float* CK, const float* CV, unsigned short* OX, SLAS unsigned char* lds) {
    const int tid = threadIdx.x, lane = tid & 63; const int w = __builtin_amdgcn_readfirstlane(tid >> 6);
    SLAS float* sc = (SLAS float*)(lds + L_SC); SLAS float* red = (SLAS float*)(lds + L_RED);
    f4 q[4];
#pragma unroll
    for (int i = 0; i < 4; ++i) q[i] = bf4(*(const unsigned long long*)(QX + (row0 + i) * 1024 + h * 256 + 4 * lane));
    const float* Kb = CK + (size_t)b * 256 * 1024 + h * 256 + 4 * lane + (size_t)w * 1024;
    const float* Vb = CV + (size_t)b * 256 * 1024 + h * 256 + 4 * lane + (size_t)w * 1024;
    const int qi = ((lane >> 5) << 1) | ((lane >> 4) & 1);
#pragma unroll 1
    for (int m0 = 0; m0 < 32; m0 += 8) {
        f4 kk[8];
#pragma unroll
        for (int j = 0; j < 8; ++j) kk[j] = *(const f4*)(Kb + (size_t)(m0 + j) * 8 * 1024);
#pragma unroll
        for (int j = 0; j < 8; ++j) { const float s = xreduce4(dot4(q[0], kk[j]), dot4(q[1], kk[j]), dot4(q[2], kk[j]), dot4(q[3], kk[j]), lane);
            if ((lane & 15) == 0) sc[(w + 8 * (m0 + j)) * 4 + qi] = s; }
    }
    __syncthreads();
    if (w < 4) {
        float v[4];
#pragma unroll
        for (int j = 0; j < 4; ++j) v[j] = sc[(lane + 64 * j) * 4 + w];
        const float mx = wave_max(fmaxf(fmaxf(v[0], v[1]), fmaxf(v[2], v[3])));
        float sum = 0.f;
#pragma unroll
        for (int j = 0; j < 4; ++j) { v[j] = exp2f(v[j] - mx); sum += v[j]; }
        const float inv = 1.0f / wave_sum(sum);
#pragma unroll
        for (int j = 0; j < 4; ++j) sc[(lane + 64 * j) * 4 + w] = v[j] * inv;
    }
    __syncthreads();
    f4 acc[4];
#pragma unroll
    for (int i = 0; i < 4; ++i) acc[i] = (f4){0.f, 0.f, 0.f, 0.f};
#pragma unroll 1
    for (int m0 = 0; m0 < 32; m0 += 8) {
        f4 vv[8];
#pragma unroll
        for (int j = 0; j < 8; ++j) vv[j] = *(const f4*)(Vb + (size_t)(m0 + j) * 8 * 1024);
#pragma unroll
        for (int j = 0; j < 8; ++j) { const f4 pm = *(const SLAS f4*)(sc + (w + 8 * (m0 + j)) * 4);
            acc[0] += pm.x * vv[j]; acc[1] += pm.y * vv[j]; acc[2] += pm.z * vv[j]; acc[3] += pm.w * vv[j]; }
    }
#pragma unroll
    for (int i = 0; i < 4; ++i) *(SLAS f4*)(red + (w * 64 + lane) * 16 + 4 * i) = acc[i];
    __syncthreads();
    { const int i = tid >> 7, d = 2 * (tid & 127); float o0 = 0.f, o1 = 0.f;
#pragma unroll
        for (int ww = 0; ww < 8; ++ww) { const SLAS float* r = red + (ww * 64 + (d >> 2)) * 16 + 4 * i + (d & 3); o0 += r[0]; o1 += r[1]; }
        *(unsigned*)(OX + (row0 + i) * 1024 + h * 256 + d) = pk2(o0, o1); }
    __syncthreads();
}
#undef SLAS
}

namespace ssb {
#define SLAS __attribute__((address_space(3)))
typedef float f4 __attribute__((ext_vector_type(4)));
constexpr int ZSEG = 20;
constexpr int L_Z = 0, L_TOT = L_Z + 4 * 128 * ZSEG * 4, L_NEW = L_TOT + 4 * 128 * 4, L_RED = L_NEW + 256, L_END = L_RED + 32 * 16 * 16 * 4;
static_assert(L_END <= 131072, "ssb LDS");
__device__ __forceinline__ f4 bf4(unsigned long long v) { const unsigned lo = (unsigned)v, hi = (unsigned)(v >> 32); return (f4){__uint_as_float(lo << 16), __uint_as_float(lo & 0xffff0000u), __uint_as_float(hi << 16), __uint_as_float(hi & 0xffff0000u)}; }
__device__ __forceinline__ float dot4(f4 a, f4 b) { return (a.x * b.x + a.y * b.y) + (a.z * b.z + a.w * b.w); }
__device__ __forceinline__ float xreduce4_16(float p0, float p1, float p2, float p3, int lane) {
    const bool b3 = (lane & 8) != 0, b2 = (lane & 4) != 0;
    const float s0 = b3 ? p0 : p2, s1 = b3 ? p1 : p3, k0 = b3 ? p2 : p0, k1 = b3 ? p3 : p1;
    const float r0 = k0 + __shfl_xor(s0, 8), r1 = k1 + __shfl_xor(s1, 8);
    float s = (b2 ? r1 : r0) + __shfl_xor(b2 ? r0 : r1, 4);
    s += __shfl_xor(s, 2); s += __shfl_xor(s, 1);
    return s;
}
__device__ __forceinline__ float lsn2(float z) { return -__builtin_amdgcn_logf(1.0f + __builtin_amdgcn_exp2f(fminf(z, 60.f))); }

__device__ __forceinline__ void item(int b, int h, long row0, const unsigned short* SQ, const unsigned short* SK, const unsigned short* SV, const float* CK, const float* CV, const int* pt, float bias2, unsigned short* OC, SLAS unsigned char* lds) {
    const int tid = threadIdx.x, lane = tid & 63, l16 = tid & 15, g = tid >> 4;
    SLAS float* zq = (SLAS float*)(lds + L_Z); SLAS float* tot = (SLAS float*)(lds + L_TOT); SLAS float* nw = (SLAS float*)(lds + L_NEW); SLAS float* red = (SLAS float*)(lds + L_RED);
    f4 q[4];
#pragma unroll
    for (int i = 0; i < 4; ++i) q[i] = bf4(*(const unsigned long long*)(SQ + (row0 + i) * 512 + h * 64 + 4 * l16));
    const int qi = (((lane >> 3) & 1) << 1) | ((lane >> 2) & 1);
#pragma unroll 1
    for (int pg = 0; pg < 16; pg += 2) {
        const float* p0 = CK + ((size_t)pt[pg] * 128 + g) * 512 + h * 64 + 4 * l16; const float* p1 = CK + ((size_t)pt[pg + 1] * 128 + g) * 512 + h * 64 + 4 * l16;
        f4 kk[8];
#pragma unroll
        for (int j = 0; j < 4; ++j) { kk[j] = *(const f4*)(p0 + (size_t)j * 32 * 512); kk[4 + j] = *(const f4*)(p1 + (size_t)j * 32 * 512); }
#pragma unroll
        for (int j = 0; j < 8; ++j) { const float s = xreduce4_16(dot4(q[0], kk[j]), dot4(q[1], kk[j]), dot4(q[2], kk[j]), dot4(q[3], kk[j]), lane) + bias2;
            const int key = 128 * pg + 32 * j + g;
            if ((lane & 3) == 0) zq[(qi * 128 + (key >> 4)) * ZSEG + (key & 15)] = s; }
    }
    if (tid < 4) {
        const int i = tid; float z0 = 0.f, z1 = 0.f, z2 = 0.f;
        for (int d = 0; d < 64; d += 4) { const f4 qq = bf4(*(const unsigned long long*)(SQ + (row0 + i) * 512 + h * 64 + d));
            z0 += dot4(qq, bf4(*(const unsigned long long*)(SK + (row0 + 0) * 512 + h * 64 + d)));
            z1 += dot4(qq, bf4(*(const unsigned long long*)(SK + (row0 + 1) * 512 + h * 64 + d)));
            z2 += dot4(qq, bf4(*(const unsigned long long*)(SK + (row0 + 2) * 512 + h * 64 + d))); }
        z0 += bias2; z1 += bias2; z2 += bias2;
        const float l0 = lsn2(z0), l1 = lsn2(z1), l2 = lsn2(z2);
        float run = 0.f, a0 = 0.f, a1 = 0.f, a2 = 0.f;
        if (i > 2) { a2 = __builtin_amdgcn_exp2f((z2 + l2) + run); run += l2; }
        if (i > 1) { a1 = __builtin_amdgcn_exp2f((z1 + l1) + run); run += l1; }
        if (i > 0) { a0 = __builtin_amdgcn_exp2f((z0 + l0) + run); run += l0; }
        nw[i * 4 + 0] = a0; nw[i * 4 + 1] = a1; nw[i * 4 + 2] = a2; nw[i * 4 + 3] = run;
    }
    __syncthreads();
    { const int i = tid & 3, sg = tid >> 2;
        SLAS float* zs = zq + (i * 128 + sg) * ZSEG;
        f4 z4[4], l4[4]; float t = 0.f;
#pragma unroll
        for (int k = 0; k < 4; ++k) { z4[k] = *(const SLAS f4*)(zs + 4 * k);
            l4[k] = (f4){lsn2(z4[k].x), lsn2(z4[k].y), lsn2(z4[k].z), lsn2(z4[k].w)}; t += (l4[k].x + l4[k].y) + (l4[k].z + l4[k].w); }
        tot[i * 128 + sg] = t;
        __syncthreads();
        float run = nw[i * 4 + 3];
        for (int s2 = sg + 1; s2 < 128; ++s2) run += tot[i * 128 + s2];
#pragma unroll
        for (int k = 3; k >= 0; --k) { f4 a;
            a.w = __builtin_amdgcn_exp2f((z4[k].w + l4[k].w) + run); run += l4[k].w;
            a.z = __builtin_amdgcn_exp2f((z4[k].z + l4[k].z) + run); run += l4[k].z;
            a.y = __builtin_amdgcn_exp2f((z4[k].y + l4[k].y) + run); run += l4[k].y;
            a.x = __builtin_amdgcn_exp2f((z4[k].x + l4[k].x) + run); run += l4[k].x;
            *(SLAS f4*)(zs + 4 * k) = a; }
    }
    __syncthreads();
    f4 acc[4];
#pragma unroll
    for (int i = 0; i < 4; ++i) acc[i] = (f4){0.f, 0.f, 0.f, 0.f};
#pragma unroll 1
    for (int pg = 0; pg < 16; pg += 2) {
        const float* p0 = CV + ((size_t)pt[pg] * 128 + g) * 512 + h * 64 + 4 * l16; const float* p1 = CV + ((size_t)pt[pg + 1] * 128 + g) * 512 + h * 64 + 4 * l16;
        f4 vv[8];
#pragma unroll
        for (int j = 0; j < 4; ++j) { vv[j] = *(const f4*)(p0 + (size_t)j * 32 * 512); vv[4 + j] = *(const f4*)(p1 + (size_t)j * 32 * 512); }
#pragma unroll
        for (int j = 0; j < 8; ++j) { const int key = 128 * pg + 32 * j + g; const SLAS float* ap = zq + (key >> 4) * ZSEG + (key & 15);
            acc[0] += ap[0] * vv[j]; acc[1] += ap[128 * ZSEG] * vv[j]; acc[2] += ap[2 * 128 * ZSEG] * vv[j]; acc[3] += ap[3 * 128 * ZSEG] * vv[j]; }
    }
#pragma unroll
    for (int i = 0; i < 4; ++i) *(SLAS f4*)(red + (g * 16 + l16) * 16 + 4 * i) = acc[i];
    __syncthreads();
    if (tid < 256) { const int i = tid >> 6, d = tid & 63; float o = 0.f;
#pragma unroll 8
        for (int gg = 0; gg < 32; ++gg) o += red[(gg * 16 + (d >> 2)) * 16 + 4 * i + (d & 3)];
        for (int j = 0; j < 3; ++j) if (j < i) o += nw[i * 4 + j] * __uint_as_float((unsigned)SV[(row0 + j) * 512 + h * 64 + d] << 16);
        OC[(row0 + i) * 1024 + h * 64 + d] = (unsigned short)f2bf(o); }
    __syncthreads();
}
#undef SLAS
}

namespace srt {
#define SLAS __attribute__((address_space(3)))
typedef float f2 __attribute__((ext_vector_type(2)));
constexpr int L_QKV = 0, L_PART = L_QKV + 2 * 4 * 3 * 128 * 4, L_DOT = L_PART + 2 * 4 * 4 * 128 * 4, L_END = L_DOT + 2 * 16 * 4;
__device__ __forceinline__ float wave_sum(float v) {
#pragma unroll
    for (int o = 1; o < 64; o <<= 1) v += __shfl_xor(v, o);
    return v; }
__device__ __forceinline__ void item2(int pi, long rowbase, const unsigned short* RQ, const unsigned short* RK, const unsigned short* RV, const float* S0, float* Sout, float* OR, SLAS unsigned char* lds) {
    const int tid = threadIdx.x, lane = tid & 63; const int w = __builtin_amdgcn_readfirstlane(tid >> 6);
    SLAS float* qkv = (SLAS float*)(lds + L_QKV); SLAS float* part = (SLAS float*)(lds + L_PART); SLAS float* dots = (SLAS float*)(lds + L_DOT);
    for (int idx = tid; idx < 2 * 4 * 3 * 128; idx += 512) {
        const int itl = idx / 1536, rem = idx % 1536, tok = rem / 384, which = (rem % 384) >> 7, d = rem & 127;
        const int it = 2 * pi + itl, b = it >> 2, h = it & 3;
        const unsigned short* src = which == 0 ? RQ : (which == 1 ? RK : RV);
        qkv[idx] = __uint_as_float((unsigned)src[(rowbase + 4 * b + tok) * 512 + h * 128 + d] << 16);
    }
    __syncthreads();
    const int itl = w >> 2, dq = w & 3, it = 2 * pi + itl, h = it & 3;
    const float gam = 1.0f - exp2f(-5.0f - (float)h), g2 = gam * gam, g3 = g2 * gam, g4 = g2 * g2;
    const SLAS float* my = qkv + itl * 1536;
    const int e2 = 2 * lane;
    f2 vj[4];
#pragma unroll
    for (int j = 0; j < 4; ++j) vj[j] = *(const SLAS f2*)(my + j * 384 + 256 + e2);
    f2 po[4];
#pragma unroll
    for (int i = 0; i < 4; ++i) po[i] = (f2){0.f, 0.f};
    const float* s0p = S0 + ((size_t)it * 128 + 32 * dq) * 128 + e2; float* snp = Sout + ((size_t)it * 128 + 32 * dq) * 128 + e2;
#pragma unroll 1
    for (int r0 = 0; r0 < 32; r0 += 8) {
        f2 s0[8];
#pragma unroll
        for (int r = 0; r < 8; ++r) s0[r] = *(const f2*)(s0p + (size_t)(r0 + r) * 128);
#pragma unroll
        for (int r = 0; r < 8; ++r) { const int d = 32 * dq + r0 + r;
            const float q0 = my[0 * 384 + d], q1 = my[1 * 384 + d], q2 = my[2 * 384 + d], q3 = my[3 * 384 + d];
            const float k0 = my[0 * 384 + 128 + d] * g3, k1 = my[1 * 384 + 128 + d] * g2, k2 = my[2 * 384 + 128 + d] * gam, k3 = my[3 * 384 + 128 + d];
            po[0] += q0 * s0[r]; po[1] += q1 * s0[r]; po[2] += q2 * s0[r]; po[3] += q3 * s0[r];
            const f2 sn = g4 * s0[r] + k0 * vj[0] + k1 * vj[1] + k2 * vj[2] + k3 * vj[3];
            *(f2*)(snp + (size_t)(r0 + r) * 128) = sn; }
    }
#pragma unroll
    for (int i = 0; i < 4; ++i) *(SLAS f2*)(part + ((itl * 4 + dq) * 4 + i) * 128 + e2) = po[i];
    { const int i = dq;
#pragma unroll
        for (int j = 0; j < 4; ++j) { const f2 qq = *(const SLAS f2*)(my + i * 384 + e2), kk = *(const SLAS f2*)(my + j * 384 + 128 + e2);
            const float s = wave_sum(qq.x * kk.x + qq.y * kk.y); if (lane == 0) dots[itl * 16 + i * 4 + j] = s; } }
    __syncthreads();
    { const int itl2 = tid >> 8, rem = tid & 255, i = rem >> 6, ee = 2 * (rem & 63); const int it2 = 2 * pi + itl2, b2 = it2 >> 2, h2 = it2 & 3;
        const float gm = 1.0f - exp2f(-5.0f - (float)h2);
        f2 cr = (f2){0.f, 0.f};
#pragma unroll
        for (int qq = 0; qq < 4; ++qq) cr += *(const SLAS f2*)(part + ((itl2 * 4 + qq) * 4 + i) * 128 + ee);
        float gp = gm; for (int k = 0; k < i; ++k) gp *= gm;
        f2 o = gp * cr; float gd = 1.0f;
        for (int j = i; j >= 0; --j) { o += (gd * dots[itl2 * 16 + i * 4 + j]) * *(const SLAS f2*)(qkv + itl2 * 1536 + j * 384 + 256 + ee); gd *= gm; }
        *(f2*)(OR + (rowbase + 4 * b2 + i) * 512 + h2 * 128 + ee) = o; }
    __syncthreads();
}
#undef SLAS
}

constexpr int NWAVES = 8, NTHREADS = 512;
constexpr int D = 1024, SEQ = 2048, NB = 8, MP = NB * SEQ, DECB = 128, DECS = 4, MS = DECB * DECS, MT = MP + MS;
constexpr int FF = 2816, NGU = 2 * FF, NIN = 3584, NMEM = 256, MM = NB * NMEM;
constexpr int PAST = 2048, PAGE = 128, NPAGES = 16, NPOS = PAST + DECS;
constexpr float EPS = 1e-6f;
constexpr int C_QR = 0, C_KR = 512, C_VR = 1024, C_GR = 1536, C_QS = 2048, C_KS = 2560, C_VS = 3072;
constexpr size_t O_Y = 0, O_RSP = 17301504, O_SBKP = 17825792, O_SBVP = 26214400, O_MKP = 34603008, O_MVP = 36700160, O_RSS = 38797312, O_SBKS = 47185920, O_SBVS = 47448064, O_END = 47710208;
enum { I_XP = 0, I_XS, I_MEM, I_CRET, I_CSBK, I_CSBV, I_CMK, I_CMV, I_PT, I_G1PRE, I_W1G, I_W1U, I_W1D, I_G1POST, I_GMIXPRE, I_WIN, I_BSB, I_GGN, I_WOUT, I_GMIXPOST, I_GMEM, I_WMK, I_WMV, I_GXPRE, I_WXQ, I_WXO, I_GXPOST, I_G2PRE, I_W2G, I_W2U, I_W2D, I_G2POST, N_IN };

constexpr size_t MiB = 1u << 20;
constexpr size_t WS_CTL = 0, CTL_ZERO_BYTES = 1 * MiB;
constexpr size_t WS_ROPE = 1 * MiB;
constexpr size_t WS_WGU1 = 4 * MiB, WS_WD1 = 15 * MiB, WS_WIN = 21 * MiB, WS_WOUT = 28 * MiB, WS_WMKV = 30 * MiB, WS_WXQ = 34 * MiB, WS_WXO = 36 * MiB, WS_WGU2 = 38 * MiB, WS_WD2 = 49 * MiB;
constexpr size_t WS_XN = 64 * MiB, WS_MN = 97 * MiB, WS_CAT = 101 * MiB, WS_OX = 134 * MiB, WS_H = 167 * MiB, WS_C2 = 258 * MiB, WS_C3 = 324 * MiB, WS_C1 = 555 * MiB, WS_OR = 918 * MiB, WS_OS = 951 * MiB, WS_SBQ = 984 * MiB, WS_SBK = 1001 * MiB, WS_SBV = 1018 * MiB, WS_RQ = 1035 * MiB, WS_RK = 1052 * MiB, WS_RV = 1069 * MiB, WS_QXB = 1086 * MiB, WS_MKB = 1119 * MiB, WS_MVB = 1123 * MiB, WS_END = 1127 * MiB;
static_assert(WS_WD2 + (size_t)D * FF * 2 <= WS_XN && WS_XN + (size_t)MT * D * 2 <= WS_MN && WS_H + (size_t)MT * FF * 2 <= WS_C2 && WS_C2 + (size_t)MT * D * 4 <= WS_C3 && WS_C3 + (size_t)MT * NIN * 4 <= WS_C1 && WS_C1 + (size_t)MT * NGU * 4 <= WS_OR, "ws map");
constexpr int CW_TMO = 0, CW_BAR = 4096;

constexpr int RING_BYTES = 131072, LDSCTL_OFF = RING_BYTES, MISC_OFF = LDSCTL_OFF + 320, LDS_BYTES = 147456;

struct Ctx { LAS unsigned char* lds; int tid, lane, wave, gw, ngw; };
struct Args { const void* in[N_IN]; float* out; unsigned char* ws; int ph_lo, ph_hi; };
static_assert(sizeof(Args) == N_IN * 8 + 8 + 8 + 8, "Args has no padding");

__device__ __forceinline__ float wave_sum(float v) {
#pragma unroll
    for (int o = 1; o < 64; o <<= 1) v += __shfl_xor(v, o);
    return v;
}
__device__ __forceinline__ float wave_max(float v) {
#pragma unroll
    for (int o = 1; o < 64; o <<= 1) v = fmaxf(v, __shfl_xor(v, o));
    return v;
}
__device__ __forceinline__ unsigned long long pk4(f32x4 v) { return (unsigned long long)pk2(v.x, v.y) | ((unsigned long long)pk2(v.z, v.w) << 32); }

__device__ __forceinline__ void p0_transpose_item(const float* W, int K, int N, bf16* WT, int row_off, LAS float* scr, int item, int lane, int mode = 0) {
    const int nblk = N / 32, kb = item / nblk, nb = item % nblk, k0 = 64 * kb, n0 = 32 * nb;
    const int drow0 = mode == 0 ? row_off + n0 : 256 * (nb >> 2) + 32 * (nb & 3) + (mode == 2 ? 128 : 0);
#pragma unroll 8
    for (int i = 0; i < 32; ++i) { const int kk = 2 * i + (lane >> 5); scr[kk * 33 + (lane & 31)] = W[(size_t)(k0 + kk) * N + n0 + (lane & 31)]; }
    LDS_WAIT(); asm volatile("" ::: "memory");
    const int c = lane & 7;
#pragma unroll
    for (int j = 0; j < 4; ++j) { const int n = (lane >> 3) + 8 * j; const LAS float* s = scr + (8 * c) * 33 + n;
        v4u o; o.x = pk2(s[0 * 33], s[1 * 33]); o.y = pk2(s[2 * 33], s[3 * 33]); o.z = pk2(s[4 * 33], s[5 * 33]); o.w = pk2(s[6 * 33], s[7 * 33]);
        *(GAS v4u*)(WT + (size_t)(drow0 + n) * K + k0 + 8 * c) = o; }
    LDS_WAIT(); asm volatile("" ::: "memory");
}
__device__ __forceinline__ void rms_row_to_bf16(const float* xrow, const float* g, bf16* orow, int lane) {
    const f32x4* xr = (const f32x4*)xrow + lane; const f32x4* gr = (const f32x4*)g + lane;
    f32x4 v[4]; float s = 0.f;
#pragma unroll
    for (int j = 0; j < 4; ++j) { v[j] = xr[64 * j]; s += (v[j].x * v[j].x + v[j].y * v[j].y) + (v[j].z * v[j].z + v[j].w * v[j].w); }
    const float rstd = 1.0f / sqrtf(wave_sum(s) * (1.f / D) + EPS);
    unsigned long long* o8 = (unsigned long long*)orow + lane;
#pragma unroll
    for (int j = 0; j < 4; ++j) { const f32x4 gg = gr[64 * j]; o8[64 * j] = pk4(v[j] * rstd * gg); }
}
__device__ __forceinline__ void sincos_d(double a, double& s, double& c) {
    const double TWO_OVER_PI = 0.63661977236758134308, PIO2_HI = 1.57079632679489655800e+00, PIO2_LO = 6.12323399573676603587e-17;
    const double kf = rint(a * TWO_OVER_PI); const int k = (int)kf;
    const double r = (a - kf * PIO2_HI) - kf * PIO2_LO, r2 = r * r;
    double sp = -1.0 / 1307674368000.0; sp = sp * r2 + 1.0 / 6227020800.0; sp = sp * r2 - 1.0 / 39916800.0; sp = sp * r2 + 1.0 / 362880.0; sp = sp * r2 - 1.0 / 5040.0; sp = sp * r2 + 1.0 / 120.0; sp = sp * r2 - 1.0 / 6.0; sp = sp * r2 * r + r;
    double cp = 1.0 / 20922789888000.0; cp = cp * r2 - 1.0 / 87178291200.0; cp = cp * r2 + 1.0 / 479001600.0; cp = cp * r2 - 1.0 / 3628800.0; cp = cp * r2 + 1.0 / 40320.0; cp = cp * r2 - 1.0 / 720.0; cp = cp * r2 + 1.0 / 24.0; cp = cp * r2 - 0.5; cp = cp * r2 + 1.0;
    switch (k & 3) { case 0: s = sp; c = cp; break; case 1: s = cp; c = -sp; break; case 2: s = -sp; c = -cp; break; default: s = -cp; c = sp; break; }
}

__device__ __forceinline__ void ph_prologue(const Ctx& c, const Args& a) {
    LAS float* scr = (LAS float*)(c.lds + c.wave * 16384);
    unsigned char* ws = a.ws;
    constexpr int I_G = (D / 64) * (FF / 32), I_DN = (FF / 64) * (D / 32), I_INP = (D / 64) * (NIN / 32), I_SQ = (D / 64) * (D / 32);
    constexpr int NITEMS = 4 * I_G + 2 * I_DN + I_INP + 5 * I_SQ;
    for (int it = c.gw; it < NITEMS; it += c.ngw) {
        int r = it;
        if (r < I_G) { p0_transpose_item((const float*)a.in[I_W1G], D, FF, (bf16*)(ws + WS_WGU1), 0, scr, r, c.lane, 1); continue; } r -= I_G;
        if (r < I_G) { p0_transpose_item((const float*)a.in[I_W1U], D, FF, (bf16*)(ws + WS_WGU1), FF, scr, r, c.lane, 2); continue; } r -= I_G;
        if (r < I_G) { p0_transpose_item((const float*)a.in[I_W2G], D, FF, (bf16*)(ws + WS_WGU2), 0, scr, r, c.lane, 1); continue; } r -= I_G;
        if (r < I_G) { p0_transpose_item((const float*)a.in[I_W2U], D, FF, (bf16*)(ws + WS_WGU2), FF, scr, r, c.lane, 2); continue; } r -= I_G;
        if (r < I_DN) { p0_transpose_item((const float*)a.in[I_W1D], FF, D, (bf16*)(ws + WS_WD1), 0, scr, r, c.lane); continue; } r -= I_DN;
        if (r < I_DN) { p0_transpose_item((const float*)a.in[I_W2D], FF, D, (bf16*)(ws + WS_WD2), 0, scr, r, c.lane); continue; } r -= I_DN;
        if (r < I_INP) { p0_transpose_item((const float*)a.in[I_WIN], D, NIN, (bf16*)(ws + WS_WIN), 0, scr, r, c.lane); continue; } r -= I_INP;
        if (r < I_SQ) { p0_transpose_item((const float*)a.in[I_WOUT], D, D, (bf16*)(ws + WS_WOUT), 0, scr, r, c.lane); continue; } r -= I_SQ;
        if (r < I_SQ) { p0_transpose_item((const float*)a.in[I_WMK], D, D, (bf16*)(ws + WS_WMKV), 0, scr, r, c.lane); continue; } r -= I_SQ;
        if (r < I_SQ) { p0_transpose_item((const float*)a.in[I_WMV], D, D, (bf16*)(ws + WS_WMKV), D, scr, r, c.lane); continue; } r -= I_SQ;
        if (r < I_SQ) { p0_transpose_item((const float*)a.in[I_WXQ], D, D, (bf16*)(ws + WS_WXQ), 0, scr, r, c.lane); continue; } r -= I_SQ;
        p0_transpose_item((const float*)a.in[I_WXO], D, D, (bf16*)(ws + WS_WXO), 0, scr, r, c.lane);
    }
    float2* rope = (float2*)(ws + WS_ROPE);
    for (int idx = c.gw * 64 + c.lane; idx < NPOS * 64; idx += c.ngw * 64) {
        const int pos = idx >> 6, i = idx & 63;
        double inv = 1.0; for (int k = 0; k < i; ++k) inv *= 0.8659643233600653;
        double s, co; sincos_d((double)pos * inv, s, co);
        rope[idx] = make_float2((float)co, (float)s);
    }
    for (int m = c.gw; m < MT; m += c.ngw) {
        const float* src = m < MP ? (const float*)a.in[I_XP] + (size_t)m * D : (const float*)a.in[I_XS] + (size_t)(m - MP) * D;
        rms_row_to_bf16(src, (const float*)a.in[I_G1PRE], (bf16*)(ws + WS_XN) + (size_t)m * D, c.lane);
    }
    for (int m = c.gw; m < MM; m += c.ngw)
        rms_row_to_bf16((const float*)a.in[I_MEM] + (size_t)m * D, (const float*)a.in[I_GMEM], (bf16*)(ws + WS_MN) + (size_t)m * D, c.lane);
}

__device__ __forceinline__ void ph_swiglu(const Ctx& c, const float* C1, bf16* H) {
    constexpr int Q = FF / 4;
    const size_t total = (size_t)MT * Q;
    for (size_t idx = (size_t)blockIdx.x * NTHREADS + c.tid; idx < total; idx += (size_t)gridDim.x * NTHREADS) {
        const int r = (int)(idx / Q), q = (int)(idx % Q);
        const f32x4 g = *(const f32x4*)(C1 + (size_t)r * NGU + 4 * q), u = *(const f32x4*)(C1 + (size_t)r * NGU + FF + 4 * q);
        f32x4 h; h.x = g.x / (1.f + expf(-g.x)) * u.x; h.y = g.y / (1.f + expf(-g.y)) * u.y; h.z = g.z / (1.f + expf(-g.z)) * u.z; h.w = g.w / (1.f + expf(-g.w)) * u.w;
        *(unsigned long long*)(H + (size_t)r * FF + 4 * q) = pk4(h);
    }
}

template <bool FIRST, bool FINAL>
__device__ __forceinline__ void ph_post(const Ctx& c, const Args& a, const float* C2, float scale, const float* gpost, const float* gpre) {
    float* hout = a.out + O_Y; bf16* XN = (bf16*)(a.ws + WS_XN);
    for (int m = c.gw; m < MT; m += c.ngw) {
        const float* base = FIRST ? (m < MP ? (const float*)a.in[I_XP] + (size_t)m * D : (const float*)a.in[I_XS] + (size_t)(m - MP) * D) : hout + (size_t)m * D;
        const f32x4* cr = (const f32x4*)(C2 + (size_t)m * D) + c.lane; const f32x4* br = (const f32x4*)base + c.lane; const f32x4* g1 = (const f32x4*)gpost + c.lane;
        f32x4 v[4]; float s = 0.f;
#pragma unroll
        for (int j = 0; j < 4; ++j) { v[j] = cr[64 * j]; s += (v[j].x * v[j].x + v[j].y * v[j].y) + (v[j].z * v[j].z + v[j].w * v[j].w); }
        const float rstd = scale / sqrtf(wave_sum(s) * (1.f / D) + EPS);
        float s2 = 0.f;
#pragma unroll
        for (int j = 0; j < 4; ++j) { v[j] = br[64 * j] + v[j] * rstd * g1[64 * j]; s2 += (v[j].x * v[j].x + v[j].y * v[j].y) + (v[j].z * v[j].z + v[j].w * v[j].w); }
        f32x4* ho = (f32x4*)(hout + (size_t)m * D) + c.lane;
#pragma unroll
        for (int j = 0; j < 4; ++j) ho[64 * j] = v[j];
        if (!FINAL) {
            const float rstd2 = 1.0f / sqrtf(wave_sum(s2) * (1.f / D) + EPS);
            const f32x4* g2 = (const f32x4*)gpre + c.lane; unsigned long long* o8 = (unsigned long long*)(XN + (size_t)m * D) + c.lane;
#pragma unroll
            for (int j = 0; j < 4; ++j) o8[64 * j] = pk4(v[j] * rstd2 * g2[64 * j]);
        }
    }
}

__device__ __forceinline__ void ph_inproj_post(const Ctx& c, const Args& a) {
    float* C3 = (float*)(a.ws + WS_C3); const float2* rope = (const float2*)(a.ws + WS_ROPE);
    for (int r = c.gw; r < MT; r += c.ngw) {
        const int pos = r < MP ? (r & (SEQ - 1)) : PAST + ((r - MP) & (DECS - 1));
        float* row = C3 + (size_t)r * NIN;
        const float2 cs = rope[pos * 64 + c.lane];
#pragma unroll
        for (int h = 0; h < 4; ++h) {
            { float* p = row + C_QR + h * 128 + c.lane; const float x1 = p[0], x2 = p[64]; const float o1 = x1 * cs.x - x2 * cs.y, o2 = x1 * cs.y + x2 * cs.x; p[0] = o1; p[64] = o2;
              bf16* bq = (bf16*)(a.ws + WS_RQ) + (size_t)r * 512 + h * 128 + c.lane; bq[0] = (bf16)f2bf(o1); bq[64] = (bf16)f2bf(o2); }
            { float* p = row + C_KR + h * 128 + c.lane; const float x1 = p[0], x2 = p[64]; const float o1 = (x1 * cs.x - x2 * cs.y) * 0.08838834764831845f, o2 = (x1 * cs.y + x2 * cs.x) * 0.08838834764831845f; p[0] = o1; p[64] = o2;
              bf16* bk = (bf16*)(a.ws + WS_RK) + (size_t)r * 512 + h * 128 + c.lane; bk[0] = (bf16)f2bf(o1); bk[64] = (bf16)f2bf(o2); }
        }
        { const int col = 8 * c.lane; const f32x4 v0 = *(const f32x4*)(row + C_VR + col), v1 = *(const f32x4*)(row + C_VR + col + 4);
          unsigned long long* ov = (unsigned long long*)((bf16*)(a.ws + WS_RV) + (size_t)r * 512 + col); ov[0] = pk4(v0); ov[1] = pk4(v1); }
        float* dk = r < MP ? a.out + O_SBKP + (size_t)r * 512 : a.out + O_SBKS + (size_t)(r - MP) * 512;
        float* dv = r < MP ? a.out + O_SBVP + (size_t)r * 512 : a.out + O_SBVS + (size_t)(r - MP) * 512;
#pragma unroll
        for (int j = 0; j < 2; ++j) { ((f32x4*)dk)[c.lane + 64 * j] = ((const f32x4*)(row + C_KS))[c.lane + 64 * j]; ((f32x4*)dv)[c.lane + 64 * j] = ((const f32x4*)(row + C_VS))[c.lane + 64 * j]; }
        { const int col = 8 * c.lane; const float qs = 0.125f * 1.4426950408889634f;
          const f32x4 a0 = *(const f32x4*)(row + C_QS + col) * qs, a1 = *(const f32x4*)(row + C_QS + col + 4) * qs;
          unsigned long long* oq = (unsigned long long*)((bf16*)(a.ws + WS_SBQ) + (size_t)r * 512 + col); oq[0] = pk4(a0); oq[1] = pk4(a1);
          const f32x4 k0 = *(const f32x4*)(row + C_KS + col), k1 = *(const f32x4*)(row + C_KS + col + 4);
          unsigned long long* ok = (unsigned long long*)((bf16*)(a.ws + WS_SBK) + (size_t)r * 512 + col); ok[0] = pk4(k0); ok[1] = pk4(k1);
          const f32x4 v0 = *(const f32x4*)(row + C_VS + col), v1 = *(const f32x4*)(row + C_VS + col + 4);
          unsigned long long* ov = (unsigned long long*)((bf16*)(a.ws + WS_SBV) + (size_t)r * 512 + col); ov[0] = pk4(v0); ov[1] = pk4(v1); }
    }
}

__device__ __forceinline__ void ph_mixout(const Ctx& c, const Args& a) {
    const float* C3 = (const float*)(a.ws + WS_C3); const float* OR = (const float*)(a.ws + WS_OR); const float* OS = (const float*)(a.ws + WS_OS); bf16* CAT = (bf16*)(a.ws + WS_CAT);
    const float* ggn = (const float*)a.in[I_GGN];
    for (int r = c.gw; r < MT; r += c.ngw) {
        const int col = 8 * c.lane;
        const f32x4 x0 = *(const f32x4*)(OR + (size_t)r * 512 + col), x1 = *(const f32x4*)(OR + (size_t)r * 512 + col + 4);
        float s = (x0.x + x0.y) + (x0.z + x0.w) + (x1.x + x1.y) + (x1.z + x1.w);
        s += __shfl_xor(s, 1); s += __shfl_xor(s, 2); s += __shfl_xor(s, 4); s += __shfl_xor(s, 8);
        const float mu = s * (1.f / 128.f);
        const f32x4 d0 = x0 - mu, d1 = x1 - mu;
        float q = (d0.x * d0.x + d0.y * d0.y) + (d0.z * d0.z + d0.w * d0.w) + (d1.x * d1.x + d1.y * d1.y) + (d1.z * d1.z + d1.w * d1.w);
        q += __shfl_xor(q, 1); q += __shfl_xor(q, 2); q += __shfl_xor(q, 4); q += __shfl_xor(q, 8);
        const float rstd = 1.0f / sqrtf(q * (1.f / 128.f) + EPS);
        const f32x4 g0 = *(const f32x4*)(ggn + col), g1 = *(const f32x4*)(ggn + col + 4);
        const f32x4 r0 = *(const f32x4*)(C3 + (size_t)r * NIN + C_GR + col), r1 = *(const f32x4*)(C3 + (size_t)r * NIN + C_GR + col + 4);
        f32x4 y0, y1;
        y0.x = d0.x * rstd * g0.x * (r0.x / (1.f + expf(-r0.x))); y0.y = d0.y * rstd * g0.y * (r0.y / (1.f + expf(-r0.y))); y0.z = d0.z * rstd * g0.z * (r0.z / (1.f + expf(-r0.z))); y0.w = d0.w * rstd * g0.w * (r0.w / (1.f + expf(-r0.w)));
        y1.x = d1.x * rstd * g1.x * (r1.x / (1.f + expf(-r1.x))); y1.y = d1.y * rstd * g1.y * (r1.y / (1.f + expf(-r1.y))); y1.z = d1.z * rstd * g1.z * (r1.z / (1.f + expf(-r1.z))); y1.w = d1.w * rstd * g1.w * (r1.w / (1.f + expf(-r1.w)));
        unsigned long long* o = (unsigned long long*)(CAT + (size_t)r * D + col); o[0] = pk4(y0); o[1] = pk4(y1);

    }
}

__device__ __forceinline__ void ph_cross(const Ctx& c, const Args& a) {
    const bf16* QX = (const bf16*)(a.ws + WS_QXB); bf16* OX = (bf16*)(a.ws + WS_OX);
    if (blockIdx.x < 256) { const int u = (int)blockIdx.x;
        const int tile = u >> 2, head = u & 3, b = tile >> 3;
        crs::unit(QX + (size_t)tile * 256 * D + head * 256, (const bf16*)(a.ws + WS_MKB) + (size_t)b * NMEM * D + head * 256, (const bf16*)(a.ws + WS_MVB) + (size_t)b * NMEM * D + head * 256,
                  OX + (size_t)tile * 256 * D + head * 256, c.lds);
    }
    __syncthreads();
    for (int it = (int)blockIdx.x; it < DECB * 4; it += (int)gridDim.x) {
        const int b = it >> 2, h = it & 3;
        scr::item(b, h, (long)MP + 4 * b, QX, (const float*)a.in[I_CMK], (const float*)a.in[I_CMV], OX, c.lds);
    }
}

__device__ __forceinline__ void ph_gemm_f32(const Ctx& c, const bf16* A, const bf16* Bt, int M, int N, int K, float* C, int ldc, int split_cols, size_t split_stride, int cid) {
    pg8::Gemm g{A, Bt, M, N, K}; pg8::StaticOrder S; S.init(M, N, (int)gridDim.x, cid);
    pg8::EpiF32 E{C, ldc, split_cols, split_stride};
    pg8::gemm_phase<pg8::EpiF32, pg8::StaticOrder, true, true>(c.lds, g, S, E);
}

__device__ __forceinline__ void ph_gemm_f32b(const Ctx& c, const bf16* A, const bf16* Bt, int M, int N, int K, float* C, bf16* Cb, int ldc, int split_cols, size_t split_stride, size_t split_stride_b, int cid) {
    pg8::Gemm g{A, Bt, M, N, K}; pg8::StaticOrder S; S.init(M, N, (int)gridDim.x, cid);
    pg8::EpiF32B E{C, Cb, ldc, split_cols, split_stride, split_stride_b};
    pg8::gemm_phase<pg8::EpiF32B, pg8::StaticOrder, true, true>(c.lds, g, S, E);
}
__device__ __forceinline__ void ph_gemm_bf16(const Ctx& c, const bf16* A, const bf16* Bt, int M, int N, int K, bf16* O, int ldc, float scale, int cid) {
    pg8::Gemm g{A, Bt, M, N, K}; pg8::StaticOrder S; S.init(M, N, (int)gridDim.x, cid);
    pg8::EpiBf16<0> E{O, ldc, nullptr, N, 0, scale};
    pg8::gemm_phase<pg8::EpiBf16<0>, pg8::StaticOrder, true, true>(c.lds, g, S, E);
}

__device__ __forceinline__ void ph_gemm_swiglu(const Ctx& c, const bf16* A, const bf16* Bt, bf16* Hout, int cid) {
    pg8::Gemm g{A, Bt, MT, NGU, D}; pg8::StaticOrder S; S.init(MT, NGU, (int)gridDim.x, cid);
    pg8::EpiSwiglu E{Hout, FF};
    pg8::gemm_phase<pg8::EpiSwiglu, pg8::StaticOrder, true, true>(c.lds, g, S, E);
}

constexpr int NPH = 19;
__global__ void __launch_bounds__(NTHREADS, 2) fwd(Args args) {
    extern __shared__ __attribute__((aligned(16))) unsigned char lds_raw[];
    Ctx c; c.lds = (LAS unsigned char*)lds_raw; c.tid = threadIdx.x; c.lane = c.tid & 63; c.wave = __builtin_amdgcn_readfirstlane(c.tid >> 6);
    c.gw = blockIdx.x * NWAVES + c.wave; c.ngw = gridDim.x * NWAVES;
    volatile LAS unsigned* MISC = (volatile LAS unsigned*)(c.lds + MISC_OFF);
    for (int u = c.tid; u < (LDS_BYTES - LDSCTL_OFF) / 4; u += NTHREADS) ((LAS unsigned*)(c.lds + LDSCTL_OFF))[u] = 0u;
    __syncthreads();
    unsigned char* ws = args.ws;
    const int lo = args.ph_lo, hi = args.ph_hi;
    const bool multi = (hi - lo) > 1;
    XcdBarrier bar; bar.bar = (unsigned*)(ws + WS_CTL) + CW_BAR; bar.x = 0; bar.st = nullptr;
    if (multi) bar = xcd_barrier_post((unsigned*)(ws + WS_CTL) + CW_BAR, MISC + 8);
#define IN(k) (lo <= (k) && (k) < hi)
#define SEAM(k) do { if (IN(k) && hi > (k) + 1) xcd_barrier(bar); } while (0)
    bf16* XN = (bf16*)(ws + WS_XN); bf16* H = (bf16*)(ws + WS_H); float* C1 = (float*)(ws + WS_C1); float* C2 = (float*)(ws + WS_C2); float* C3 = (float*)(ws + WS_C3);
    const int cid = (int)blockIdx.x;

    if (IN(0)) { ph_prologue(c, args); } SEAM(0);
    if (IN(1)) { ph_gemm_swiglu(c, XN, (const bf16*)(ws + WS_WGU1), H, cid);
                 ph_gemm_f32b(c, (const bf16*)(ws + WS_MN), (const bf16*)(ws + WS_WMKV), MM, 2 * D, D, args.out + O_MKP, (bf16*)(ws + WS_MKB), D, D, (size_t)(O_MVP - O_MKP), (size_t)(WS_MVB - WS_MKB) / 2, (cid + 84) & 255); } SEAM(1);
    if (IN(3)) { ph_gemm_f32(c, H, (const bf16*)(ws + WS_WD1), MT, D, FF, C2, D, 0, 0, cid); } SEAM(3);
    if (IN(4)) { ph_post<true, false>(c, args, C2, 0.5f, (const float*)args.in[I_G1POST], (const float*)args.in[I_GMIXPRE]); } SEAM(4);
    if (IN(5)) { ph_gemm_f32(c, XN, (const bf16*)(ws + WS_WIN), MT, NIN, D, C3, NIN, 0, 0, cid); } SEAM(5);
    if (IN(6)) { ph_inproj_post(c, args); } SEAM(6);
    if (IN(7)) {
        const int bid = (int)blockIdx.x;
        const bf16* RQ = (const bf16*)(ws + WS_RQ); const bf16* RK = (const bf16*)(ws + WS_RK); const bf16* RV = (const bf16*)(ws + WS_RV);
        const bf16* SQ = (const bf16*)(ws + WS_SBQ); const bf16* SK = (const bf16*)(ws + WS_SBK); const bf16* SV = (const bf16*)(ws + WS_SBV); bf16* OC = (bf16*)(ws + WS_CAT) + 512;
        float* ORb = (float*)(ws + WS_OR);
        if (bid < 32) retp::unit(bid >> 2, bid & 3, RQ, RK, RV, ORb, args.out + O_RSP + (size_t)bid * 16384, c.lds);
        __syncthreads();
        if (bid < 256) { const int bh = bid >> 2, sq = bid & 3; const float bias2 = ((const float*)args.in[I_BSB])[bh & 7] * 1.4426950408889634f;
            sbp::unit(bh >> 3, bh & 7, 7 - sq, SQ, SK, SV, OC, bias2, c.lds); sbp::unit(bh >> 3, bh & 7, sq, SQ, SK, SV, OC, bias2, c.lds); }
        __syncthreads();
        for (int pi = bid; pi < DECB * 2; pi += (int)gridDim.x) srt::item2(pi, (long)MP, RQ, RK, RV, (const float*)args.in[I_CRET], args.out + O_RSS, ORb, c.lds);
        for (int it = bid; it < DECB * 8; it += (int)gridDim.x) { const int sb = it >> 3, sh = it & 7;
            ssb::item(sb, sh, (long)MP + 4 * sb, SQ, SK, SV, (const float*)args.in[I_CSBK], (const float*)args.in[I_CSBV], (const int*)args.in[I_PT] + sb * NPAGES, ((const float*)args.in[I_BSB])[sh] * 1.4426950408889634f, OC, c.lds); }
    } SEAM(7);
    if (IN(8)) { ph_mixout(c, args); } SEAM(8);
    if (IN(9)) { ph_gemm_f32(c, (const bf16*)(ws + WS_CAT), (const bf16*)(ws + WS_WOUT), MT, D, D, C2, D, 0, 0, cid); } SEAM(9);
    if (IN(10)) { ph_post<false, false>(c, args, C2, 1.0f, (const float*)args.in[I_GMIXPOST], (const float*)args.in[I_GXPRE]); } SEAM(10);
    if (IN(11)) { ph_gemm_bf16(c, XN, (const bf16*)(ws + WS_WXQ), MT, D, D, (bf16*)(ws + WS_QXB), D, 0.0625f * 1.4426950408889634f, cid); } SEAM(11);
    if (IN(12)) { ph_cross(c, args); } SEAM(12);
    if (IN(13)) { ph_gemm_f32(c, (const bf16*)(ws + WS_OX), (const bf16*)(ws + WS_WXO), MT, D, D, C2, D, 0, 0, cid); } SEAM(13);
    if (IN(14)) { ph_post<false, false>(c, args, C2, 1.0f, (const float*)args.in[I_GXPOST], (const float*)args.in[I_G2PRE]); } SEAM(14);
    if (IN(15)) { ph_gemm_swiglu(c, XN, (const bf16*)(ws + WS_WGU2), H, cid); } SEAM(15);
    if (IN(17)) { ph_gemm_f32(c, H, (const bf16*)(ws + WS_WD2), MT, D, FF, C2, D, 0, 0, cid); } SEAM(17);
    if (IN(18)) { ph_post<false, true>(c, args, C2, 0.5f, (const float*)args.in[I_G2POST], nullptr); }
#undef IN
#undef SEAM
}

#ifndef MK_ONE_LAUNCH
#define MK_ONE_LAUNCH 1
#endif
extern "C" void kernel_launch(void* const* d_in, const int* in_sizes, int n_in, void* d_out, int out_size, void* d_ws, size_t ws_size, hipStream_t stream) {
    static int grid = 0;
    if (grid == 0) {
        if (n_in != N_IN || (size_t)out_size != O_END || ws_size < WS_END) { fprintf(stderr, "kernel_launch: unexpected shapes: n_in %d out %d ws %zu; nothing launched\n", n_in, out_size, ws_size); grid = -1; return; }
        int dev = 0, cus = 0, per_cu = 0;
        if (hipGetDevice(&dev) != hipSuccess || hipDeviceGetAttribute(&cus, hipDeviceAttributeMultiprocessorCount, dev) != hipSuccess) { grid = -1; return; }
        if (hipFuncSetAttribute((const void*)fwd, hipFuncAttributeMaxDynamicSharedMemorySize, LDS_BYTES) != hipSuccess) { fprintf(stderr, "kernel_launch: hipFuncSetAttribute failed\n"); grid = -1; return; }
        if (hipOccupancyMaxActiveBlocksPerMultiprocessor(&per_cu, (const void*)fwd, NTHREADS, LDS_BYTES) != hipSuccess || per_cu < 1) fprintf(stderr, "kernel_launch: occupancy query reports %d\n", per_cu);
        (void)hipGetLastError();
        grid = cus;
        if (grid != 256) fprintf(stderr, "kernel_launch: %d CUs (expected 256)\n", grid);
    }
    if (grid < 0) return;
    if (hipMemsetAsync((char*)d_ws + WS_CTL, 0, CTL_ZERO_BYTES, stream) != hipSuccess) return;
    Args a{};
    for (int i = 0; i < N_IN; ++i) a.in[i] = d_in[i];
    a.out = (float*)d_out; a.ws = (unsigned char*)d_ws;
#if MK_ONE_LAUNCH
    a.ph_lo = 0; a.ph_hi = NPH;
    hipLaunchKernelGGL(fwd, dim3(grid), dim3(NTHREADS), LDS_BYTES, stream, a);
#else
    for (int p = 0; p < NPH; ++p) { a.ph_lo = p; a.ph_hi = p + 1; hipLaunchKernelGGL(fwd, dim3(grid), dim3(NTHREADS), LDS_BYTES, stream, a); }
#endif
}
```
